# Optimizing an MI355X kernel written in HIP

```python
import math
import jax, jax.numpy as jnp
from jax import lax
import numpy as np

D_MODEL = 2048
BATCH = 1
SEQ = 8192
DEPTH = 2

HYENA_WIDTH = D_MODEL // 2
HYENA_ORDER = 2
SHORT_CONV = 3
POS_EMB_DIM = 33
POS_BANDS = (POS_EMB_DIM - 1) // 2
FILTER_HIDDEN = 64
FAST_DECAY_PCT = 0.3
SLOW_DECAY_PCT = 1.5
DECAY_TARGET = 1e-2
MIN_DECAY = math.log(DECAY_TARGET) / SLOW_DECAY_PCT
MAX_DECAY = math.log(DECAY_TARGET) / FAST_DECAY_PCT

GLA_WIDTH = D_MODEL // 2
GLA_HEADS = 4
GLA_DK_TOTAL = GLA_WIDTH // 2
GLA_DV_TOTAL = GLA_WIDTH
GLA_DK = GLA_DK_TOTAL // GLA_HEADS
GLA_DV = GLA_DV_TOTAL // GLA_HEADS
GLA_LOWRANK = 16
GLA_GATE_TAU = 16.0
GLA_CHUNK = 64

FFN_DIM = 5632
N_EXPERTS = 8
TOP_K = 2
EXPERT_DIM = 5632
N_DENSE = (DEPTH + 1) // 2
N_MOE = DEPTH // 2

RMS_EPS = 1e-6

IN_SPLITS = ((HYENA_ORDER + 1) * HYENA_WIDTH, GLA_DK_TOTAL, GLA_DK_TOTAL, GLA_DV_TOTAL,
             GLA_DV_TOTAL, 2 * GLA_LOWRANK, D_MODEL, D_MODEL)
P_IN = sum(IN_SPLITS)

kernel_name = "hyena_gla_gated_parallel_moe_encoder"


def rmsnorm(x, g):
    xf = x.astype(jnp.float32)
    y = xf * lax.rsqrt(jnp.mean(xf * xf, axis=-1, keepdims=True) + RMS_EPS)
    return (y * g.astype(jnp.float32)).astype(x.dtype)


def split_cols(p, sizes):
    offs = np.cumsum(np.array(sizes))[:-1].tolist()
    return jnp.split(p, offs, axis=-1)


def short_conv(u, w, b):
    L = u.shape[1]
    pad = SHORT_CONV // 2
    up = jnp.pad(u, ((0, 0), (pad, SHORT_CONV - 1 - pad), (0, 0)))
    return sum(up[:, i:i + L] * w[i] for i in range(SHORT_CONV)) + b


def hyena_kernel_spectra(L, w1, b1, f1, w2, b2, f2, w3, b3, f3, w4):
    t = jnp.linspace(0.0, 1.0, L, dtype=jnp.float32)[:, None]
    omega = 2.0 * math.pi * jnp.arange(L, dtype=jnp.float32)[:, None] / L
    bands = jnp.linspace(1e-4, POS_BANDS - 1, POS_BANDS, dtype=jnp.float32)[None, :]
    z = jnp.concatenate([t, jnp.cos(bands * omega), -jnp.sin(bands * omega)], axis=-1)
    h = jnp.sin(f1 * (z @ w1 + b1))
    h = jnp.sin(f2 * (h @ w2 + b2))
    h = jnp.sin(f3 * (h @ w3 + b3))
    h = (h @ w4).astype(jnp.float32).reshape(L, HYENA_ORDER, 2, HYENA_WIDTH)
    deltas = jnp.abs(jnp.linspace(MIN_DECAY, MAX_DECAY, HYENA_WIDTH, dtype=jnp.float32))
    h = h * jnp.exp(-t * deltas)[:, None, None, :]
    fwd, bwd = h[:, :, 0], h[:, :, 1]
    k = jnp.concatenate([fwd, jnp.zeros((1, HYENA_ORDER, HYENA_WIDTH), jnp.float32), bwd[:0:-1]], axis=0)
    k = k / jnp.sum(jnp.abs(k), axis=0, keepdims=True)
    return jnp.fft.rfft(k, axis=0)


def long_conv(u, k_f, skip):
    L = u.shape[1]
    y = jnp.fft.irfft(jnp.fft.rfft(u, n=2 * L, axis=1) * k_f[None], n=2 * L, axis=1)[:, :L]
    return y + u * skip


def hyena_mixer(u, conv_w, conv_b, filt, skip):
    L = u.shape[1]
    u = short_conv(u, conv_w, conv_b)
    parts = jnp.split(u, HYENA_ORDER + 1, axis=-1)
    z = parts[0].astype(jnp.float32)
    k_f = hyena_kernel_spectra(L, *filt)
    for n in range(HYENA_ORDER):
        z = parts[n + 1].astype(jnp.float32) * long_conv(z, k_f[:, n], skip[n].astype(jnp.float32))
    return z.astype(u.dtype)


def gla_chunked(q, k, v, log_a, strict):
    B, L, H, DK = q.shape
    DV = v.shape[-1]
    N = L // GLA_CHUNK

    def to_chunks(t):
        return t.reshape(B, N, GLA_CHUNK, H, t.shape[-1]).transpose(0, 3, 1, 2, 4)

    q, k, v, la = to_chunks(q), to_chunks(k), to_chunks(v), to_chunks(log_a)
    b = jnp.cumsum(la, axis=-2)
    b_last = b[..., -1:, :]
    q_in = q * jnp.exp(b)
    k_in = k * jnp.exp(-b)
    k_out = k * jnp.exp(b_last - b)
    mask = jnp.tril(jnp.ones((GLA_CHUNK, GLA_CHUNK), dtype=bool), k=-1 if strict else 0)
    scores = jnp.where(mask, jnp.einsum("bhnik,bhnjk->bhnij", q_in, k_in), 0.0)
    o_intra = jnp.einsum("bhnij,bhnjv->bhniv", scores, v)
    d_state = jnp.einsum("bhnjk,bhnjv->bhnkv", k_out, v)
    decay = jnp.exp(b_last[..., 0, :])

    def step(S, inp):
        dS_n, d_n = inp
        return S * d_n[..., None] + dS_n, S

    S0 = jnp.zeros_like(d_state[:, :, 0])
    _, S_in = lax.scan(step, S0, (jnp.moveaxis(d_state, 2, 0), jnp.moveaxis(decay, 2, 0)))
    S_in = jnp.moveaxis(S_in, 0, 2)
    o = o_intra + jnp.einsum("bhnik,bhnkv->bhniv", q_in, S_in)
    return o.transpose(0, 2, 3, 1, 4).reshape(B, L, H, DV)


def gla_mixer(q, k, v, r, lr, gate_w2, gate_b, norm_g):
    B, L, _ = q.shape
    f32 = jnp.float32
    q = q.astype(f32).reshape(B, L, GLA_HEADS, GLA_DK) * (GLA_DK ** -0.5)
    k = k.astype(f32).reshape(B, L, GLA_HEADS, GLA_DK)
    v = v.astype(f32).reshape(B, L, GLA_HEADS, GLA_DV)
    lr_f, lr_b = jnp.split(lr, 2, axis=-1)

    def log_gate(lr_d, w2, bias):
        g = jax.nn.log_sigmoid((lr_d @ w2 + bias).astype(f32)) / GLA_GATE_TAU
        return g.reshape(B, L, GLA_HEADS, GLA_DK)

    la_f = log_gate(lr_f, gate_w2[0], gate_b[0])
    la_b = log_gate(lr_b, gate_w2[1], gate_b[1])
    flip = lambda t: t[:, ::-1]
    o = gla_chunked(q, k, v, la_f, strict=False) + flip(
        gla_chunked(flip(q), flip(k), flip(v), flip(la_b), strict=True))
    o = rmsnorm(o, norm_g).reshape(B, L, GLA_DV_TOTAL)
    return (o * jax.nn.silu(r.astype(f32))).astype(r.dtype)


def swiglu(h, wg, wu, wd):
    return (jax.nn.silu(h @ wg) * (h @ wu)) @ wd


def moe_ffn(h, router_w, wg, wu, wd):
    logits = (h @ router_w).astype(jnp.float32)
    top_vals, top_idx = lax.top_k(logits, TOP_K)
    gates = jax.nn.softmax(top_vals, axis=-1)
    combine = jnp.einsum("blk,blke->ble", gates, jax.nn.one_hot(top_idx, N_EXPERTS, dtype=jnp.float32))
    out = jnp.zeros_like(h)
    for e in range(N_EXPERTS):
        out = out + combine[..., e:e + 1].astype(h.dtype) * swiglu(h, wg[e], wu[e], wd[e])
    return out


def setup_inputs(seed: int = 0) -> dict:
    key = jax.random.key(seed)
    ks = iter(jax.random.split(key, 40))
    D, NL = D_MODEL, DEPTH
    HC = (HYENA_ORDER + 1) * HYENA_WIDTH

    def nrm(shape, scale):
        return scale * jax.random.normal(next(ks), shape, jnp.float32)

    def gain(shape):
        return 1.0 + 0.02 * jax.random.normal(next(ks), shape, jnp.float32)

    return {
        "x": nrm((BATCH, SEQ, D), 1.0),
        "norm_mix": gain((NL, D)),
        "w_in": nrm((NL, D, P_IN), D ** -0.5),
        "conv_w": nrm((NL, SHORT_CONV, HC), SHORT_CONV ** -0.5),
        "conv_b": nrm((NL, HC), 0.02),
        "filt_w1": nrm((NL, POS_EMB_DIM, FILTER_HIDDEN), POS_EMB_DIM ** -0.5),
        "filt_b1": nrm((NL, FILTER_HIDDEN), 0.1),
        "filt_freq1": 1.0 + nrm((NL, FILTER_HIDDEN), 0.1),
        "filt_w2": nrm((NL, FILTER_HIDDEN, FILTER_HIDDEN), FILTER_HIDDEN ** -0.5),
        "filt_b2": nrm((NL, FILTER_HIDDEN), 0.1),
        "filt_freq2": 1.0 + nrm((NL, FILTER_HIDDEN), 0.1),
        "filt_w3": nrm((NL, FILTER_HIDDEN, FILTER_HIDDEN), FILTER_HIDDEN ** -0.5),
        "filt_b3": nrm((NL, FILTER_HIDDEN), 0.1),
        "filt_freq3": 1.0 + nrm((NL, FILTER_HIDDEN), 0.1),
        "filt_w4": nrm((NL, FILTER_HIDDEN, HYENA_ORDER * 2 * HYENA_WIDTH), FILTER_HIDDEN ** -0.5),
        "hyena_skip": nrm((NL, HYENA_ORDER, HYENA_WIDTH), 1.0),
        "w_branch_a": nrm((NL, HYENA_WIDTH, D), HYENA_WIDTH ** -0.5),
        "gla_gate_w2": nrm((NL, 2, GLA_LOWRANK, GLA_DK_TOTAL), GLA_LOWRANK ** -0.5),
        "gla_gate_b": nrm((NL, 2, GLA_DK_TOTAL), 0.1),
        "gla_norm": gain((NL, GLA_DV)),
        "w_branch_b": nrm((NL, GLA_DV_TOTAL, D), GLA_DV_TOTAL ** -0.5),
        "w_out": nrm((NL, D, D), D ** -0.5),
        "norm_ffn": gain((NL, D)),
        "dense_w_gate": nrm((N_DENSE, D, FFN_DIM), D ** -0.5),
        "dense_w_up": nrm((N_DENSE, D, FFN_DIM), D ** -0.5),
        "dense_w_down": nrm((N_DENSE, FFN_DIM, D), FFN_DIM ** -0.5),
        "router_w": nrm((N_MOE, D, N_EXPERTS), D ** -0.5),
        "moe_w_gate": nrm((N_MOE, N_EXPERTS, D, EXPERT_DIM), D ** -0.5),
        "moe_w_up": nrm((N_MOE, N_EXPERTS, D, EXPERT_DIM), D ** -0.5),
        "moe_w_down": nrm((N_MOE, N_EXPERTS, EXPERT_DIM, D), EXPERT_DIM ** -0.5),
        "norm_final": gain((D,)),
    }


def reference(x, norm_mix, w_in, conv_w, conv_b, filt_w1, filt_b1, filt_freq1, filt_w2, filt_b2,
              filt_freq2, filt_w3, filt_b3, filt_freq3, filt_w4, hyena_skip, w_branch_a,
              gla_gate_w2, gla_gate_b, gla_norm, w_branch_b, w_out, norm_ffn, dense_w_gate,
              dense_w_up, dense_w_down, router_w, moe_w_gate, moe_w_up, moe_w_down, norm_final):
    for l in range(DEPTH):
        h = rmsnorm(x, norm_mix[l])
        p = h @ w_in[l]
        u_hy, q, k, v, r, lr, g_a, g_b = split_cols(p, IN_SPLITS)
        filt = (filt_w1[l], filt_b1[l], filt_freq1[l], filt_w2[l], filt_b2[l], filt_freq2[l],
                filt_w3[l], filt_b3[l], filt_freq3[l], filt_w4[l])
        y_a = hyena_mixer(u_hy, conv_w[l], conv_b[l], filt, hyena_skip[l]) @ w_branch_a[l]
        y_b = gla_mixer(q, k, v, r, lr, gla_gate_w2[l], gla_gate_b[l], gla_norm[l]) @ w_branch_b[l]
        mixed = jax.nn.sigmoid(g_a) * y_a + jax.nn.sigmoid(g_b) * y_b
        x = x + mixed @ w_out[l]
        h = rmsnorm(x, norm_ffn[l])
        if l % 2 == 0:
            i = l // 2
            x = x + swiglu(h, dense_w_gate[i], dense_w_up[i], dense_w_down[i])
        else:
            i = l // 2
            x = x + moe_ffn(h, router_w[i], moe_w_gate[i], moe_w_up[i], moe_w_down[i])
    return rmsnorm(x, norm_final)
```

```cpp
#include <hip/hip_runtime.h>
#include <cstdio>
#include <cstdint>

#ifndef MK_ONE_LAUNCH
#define MK_ONE_LAUNCH 1
#endif

#define GAS __attribute__((address_space(1)))
#define LAS __attribute__((address_space(3)))
typedef unsigned short bf16;
typedef unsigned v4u __attribute__((ext_vector_type(4)));
typedef unsigned v2u __attribute__((ext_vector_type(2)));
typedef float f32x4 __attribute__((ext_vector_type(4)));
typedef float f32x2 __attribute__((ext_vector_type(2)));
typedef unsigned long long u64;
constexpr float SS_FIX = 16777216.0f, SS_UNFIX = 1.0f / 16777216.0f / 2048.0f;
typedef short bf16x8 __attribute__((ext_vector_type(8)));
#define RLX_AGENT __ATOMIC_RELAXED, __HIP_MEMORY_SCOPE_AGENT
#define LDS_WAIT() asm volatile("s_waitcnt lgkmcnt(0)" ::: "memory")
#define VM_WAIT() asm volatile("s_waitcnt vmcnt(0)" ::: "memory")

constexpr int L = 8192, D = 2048, HW = 1024, PIN = 10272, FF = 5632, NE = 8;
constexpr int NH = 4, DK = 128, DV = 256, LRK = 16, CH = 64, NCH = 128, DKT = 512, DVT = 1024;
constexpr int C_HY = 0, C_Q = 3072, C_K = 3584, C_V = 4096, C_R = 5120, C_LR = 6144, C_GA = 6176, C_GB = 8224;
constexpr float RMS_EPS = 1e-6f;
constexpr int NFFT = 16384;
constexpr int PMJ = 8208;
constexpr int MOE_ROWS = 18432;
enum { I_X = 0, I_NORM_MIX, I_W_IN, I_CONV_W, I_CONV_B, I_FW1, I_FB1, I_FF1, I_FW2, I_FB2, I_FF2, I_FW3, I_FB3, I_FF3, I_FW4, I_SKIP, I_WA, I_GW2, I_GB, I_GNORM, I_WB, I_WOUT,
       I_NORM_FFN, I_DWG, I_DWU, I_DWD, I_ROUTER, I_MWG, I_MWU, I_MWD, I_NORM_FINAL, N_IN };

constexpr size_t MiB = 1u << 20;
constexpr size_t WS_CTL = 0, CTL_ZERO_BYTES = 1 * MiB;
constexpr size_t WS_TW = 1 * MiB;
constexpr size_t WS_H3B = 2 * MiB;
constexpr size_t WS_W4T = 10 * MiB;
constexpr size_t WS_LR = 14 * MiB;
constexpr size_t WS_XRES = 16 * MiB;
constexpr size_t WS_XB = 80 * MiB;
constexpr size_t WS_W = 112 * MiB;
constexpr size_t W_HY = 0, W_REST = 12 * MiB, W_LR = 40 * MiB, W_A = 41 * MiB, W_B = 45 * MiB, W_O = 49 * MiB, W_LAYER = 57 * MiB;
constexpr size_t WS_WFF = WS_W + 2 * W_LAYER;
constexpr size_t W_GU = 0, W_DT = 44 * MiB, W_FFN = 66 * MiB;
constexpr size_t WS_PM = WS_WFF + 9 * W_FFN;
constexpr size_t PM_LAYER = (size_t)2 * 512 * PMJ * 8;
constexpr size_t WS_R = WS_PM + 130 * MiB;
constexpr size_t R_UT = WS_R, R_QKVR = WS_R + 48 * MiB, R_SG = WS_R + 96 * MiB, R_HYT = WS_R + 160 * MiB, R_HY = WS_R + 176 * MiB, R_GLA = WS_R + 192 * MiB,
                 R_MIXED = WS_R + 208 * MiB, R_QI = WS_R + 240 * MiB, R_OINTRA = WS_R + 256 * MiB, R_DST = WS_R + 288 * MiB, R_SINT = WS_R + 352 * MiB, R_DEC = WS_R + 416 * MiB,
                 R_K4T = WS_R + 288 * MiB  ;
constexpr size_t R_ACT = WS_R;
constexpr size_t R_XG = WS_R, R_ACTG = WS_R + 72 * MiB, R_YS = WS_R + 270 * MiB;
constexpr size_t R_SLAB = WS_R + 344 * MiB;
constexpr size_t R_K4T1 = WS_R + 418 * MiB;
constexpr size_t WS_END = R_K4T1 + 64 * MiB;
static_assert(R_YS + 72 * MiB <= WS_END && R_DEC + 1 * MiB <= WS_END, "ws map");
constexpr int CW_TMO = 0;
constexpr int CW_BAR = 4096;
constexpr int CW_CNT = 8192;
constexpr int CW_SUMSQ = 16384;
constexpr int CW_TOK = 131072;
static_assert((CW_TOK + 8192 * 8) * 4 <= (int)CTL_ZERO_BYTES, "ctl");
constexpr int LDS_BYTES = 155648;
constexpr int LDS_MISC = 151 * 1024;

constexpr float F8_ACTSCALE = 8.0f;
constexpr float F8_WSCALE = 64.0f, F8_ASCALE = 16.0f;
__device__ __forceinline__ unsigned f8pack4(float a0, float a1, float a2, float a3) {
    a0 = fminf(fmaxf(a0, -448.0f), 448.0f); a1 = fminf(fmaxf(a1, -448.0f), 448.0f); a2 = fminf(fmaxf(a2, -448.0f), 448.0f); a3 = fminf(fmaxf(a3, -448.0f), 448.0f);
    int w = 0; w = __builtin_amdgcn_cvt_pk_fp8_f32(a0, a1, w, false); w = __builtin_amdgcn_cvt_pk_fp8_f32(a2, a3, w, true); return (unsigned)w; }
__device__ __forceinline__ float bf2f(unsigned h) { return __builtin_bit_cast(float, h << 16); }
__device__ __forceinline__ unsigned f2bf(float f) { unsigned u = __builtin_bit_cast(unsigned, f); return (u + 0x7fffu + ((u >> 16) & 1u)) >> 16; }
__device__ __forceinline__ unsigned pk2(float lo, float hi) { return f2bf(lo) | (f2bf(hi) << 16); }
__device__ __forceinline__ float fexp(float x) { return __builtin_amdgcn_exp2f(x * 1.44269504088896341f); }
__device__ __forceinline__ float fsigmoid(float x) { return __builtin_amdgcn_rcpf(1.0f + fexp(-x)); }
__device__ __forceinline__ float fsilu(float x) { return x * fsigmoid(x); }
__device__ __forceinline__ float flogsigmoid(float x) { return fminf(x, 0.f) - 0.69314718056f * __builtin_amdgcn_logf(1.0f + fexp(-fabsf(x))); }
__device__ __forceinline__ float fsin_rev(float r) { return __builtin_amdgcn_sinf(r - floorf(r)); }
__device__ __forceinline__ float fcos_rev(float r) { return __builtin_amdgcn_cosf(r - floorf(r)); }
__device__ __forceinline__ float fsin(float x) { return fsin_rev(x * 0.15915494309189535f); }
__device__ __forceinline__ float wave_sum(float v) {
#pragma unroll
    for (int o = 1; o < 64; o <<= 1) v += __shfl_xor(v, o);
    return v;
}
__device__ __forceinline__ void lds_barrier() { asm volatile("s_waitcnt lgkmcnt(0)" ::: "memory"); __builtin_amdgcn_s_barrier(); asm volatile("" ::: "memory"); }
#define XB_TMO      128
#define XB_XCNT(j)  (256  + 64 * (j))
#define XB_XSUB(j)  (1280 + 64 * (j))
#define XB_XGEN(j)  (2304 + 64 * (j))
#define XB_TOP      3328
#define XB_TOPGEN   3392
#define XCD_BAR_WORDS 3456
#define XB_SPIN_CAP (1u << 18)
__device__ __forceinline__ unsigned xb_ld(unsigned* p)              { return __hip_atomic_load(p, __ATOMIC_RELAXED, __HIP_MEMORY_SCOPE_AGENT); }
__device__ __forceinline__ unsigned xb_add(unsigned* p, unsigned v) { return __hip_atomic_fetch_add(p, v, __ATOMIC_RELAXED, __HIP_MEMORY_SCOPE_AGENT); }
__device__ __forceinline__ unsigned xb_xcc_id() { return (unsigned)__builtin_amdgcn_s_getreg((3 << 11) | 20) & 0xFu; }
#define XB_SPIN(cond, bar) do { unsigned _sp = 0; while (cond) { __builtin_amdgcn_s_sleep(1); \
    if ((++_sp & 255u) == 0u) { if (xb_ld(&(bar)[XB_TMO])) break; if (_sp > XB_SPIN_CAP) { atomicAdd(&(bar)[XB_TMO], 1u); break; } } } } while (0)
struct XcdBarrier { unsigned* bar; unsigned x; volatile LAS unsigned* st; };
__device__ __forceinline__ XcdBarrier xcd_barrier_post(unsigned* bar, volatile LAS unsigned* st) {
    XcdBarrier b; b.bar = bar; b.x = xb_xcc_id(); b.st = st;
    if (threadIdx.x == 0) (void)xb_add(&bar[XB_XCNT(b.x)], 1u);
    return b;
}
__device__ __forceinline__ void xcd_barrier_complete(unsigned* bar, unsigned x, unsigned& nloc, unsigned& nx) {
    const unsigned G = gridDim.x * gridDim.y * gridDim.z;
    unsigned sum, cnt, mine, sp = 0u;
    for (;;) {
        sum = 0u; cnt = 0u; mine = 0u;
#pragma unroll
        for (unsigned j = 0; j < 16; ++j) { const unsigned c = xb_ld(&bar[XB_XCNT(j)]); sum += c; cnt += (c > 0u) ? 1u : 0u; mine = (j == x) ? c : mine; }
        if (sum == G) break;
        __builtin_amdgcn_s_sleep(1);
        if ((++sp & 255u) == 0u) { if (xb_ld(&bar[XB_TMO])) break; if (sp > XB_SPIN_CAP) { atomicAdd(&bar[XB_TMO], 1u); break; } }
    }
    nloc = mine > 0u ? mine : 1u; nx = cnt > 0u ? cnt : 1u;
}
__device__ __forceinline__ void xcd_barrier(const XcdBarrier& b) {
    asm volatile("s_waitcnt vmcnt(0)" ::: "memory");
    __syncthreads();
    if (threadIdx.x == 0) {
        unsigned* bar = b.bar;
        __builtin_amdgcn_s_waitcnt(0);
        unsigned nloc = b.st[0], nx = b.st[1];
        if (nloc == 0u) { xcd_barrier_complete(bar, b.x, nloc, nx); b.st[0] = nloc; b.st[1] = nx; }
        const unsigned old = xb_add(&bar[XB_XSUB(b.x)], 1u);
        const unsigned gen = old / nloc;
        if (old + 1u == (gen + 1u) * nloc) {
            __builtin_amdgcn_fence(__ATOMIC_RELEASE, "agent");
            asm volatile("s_waitcnt vmcnt(0)" ::: "memory");
            const unsigned og = xb_add(&bar[XB_TOP], 1u);
            const unsigned tg = og / nx;
            if (og + 1u == (tg + 1u) * nx) xb_add(&bar[XB_TOPGEN], 1u);
            else XB_SPIN(xb_ld(&bar[XB_TOPGEN]) == tg, bar);
            __builtin_amdgcn_fence(__ATOMIC_ACQUIRE, "agent");
            xb_add(&bar[XB_XGEN(b.x)], 1u);
            asm volatile("s_waitcnt vmcnt(0)" ::: "memory");
        } else {
            XB_SPIN(xb_ld(&bar[XB_XGEN(b.x)]) == gen, bar);
            __builtin_amdgcn_fence(__ATOMIC_ACQUIRE, "agent");
            asm volatile("s_waitcnt vmcnt(0)" ::: "memory");
        }
    }
    __syncthreads();
}

namespace pg8 {
constexpr int BM = 256, BK = 64, HALF = 128, HTB = HALF * BK * 2, STAGE_BYTES = 8 * HTB, NXCD = 8, WGM = 8;
__host__ __device__ __forceinline__ int lds_byte(int r, int c) { const int st = (r >> 4) * 2 + (c >> 5), rr = r & 15, cc = c & 31, ob = rr * 64 + cc * 2; return st * 1024 + (ob ^ (((ob >> 9) & 1) << 5)); }
__host__ __device__ __forceinline__ void stage_rc(int b, int& R, int& C) { const int st = b / 1024, sb = b % 1024, swz = sb ^ (((sb >> 9) & 1) << 5); R = (st >> 1) * 16 + swz / 64; C = (st & 1) * 32 + (swz % 64) / 2; }
__host__ __device__ __forceinline__ int perm32(int rho) { const int n = rho >> 4, i = rho & 15; return 8 * (i >> 2) + 4 * n + (i & 3); }
struct Unit { const char* A; const char* B; int pm, pn, kind; };
__device__ __forceinline__ void tile_of(int Lw, int nM, int nN, int& pm, int& pn) {
    const int nwg = nM * nN; int wgid = Lw; { const int q = nwg / NXCD, r = nwg % NXCD, xcd = wgid % NXCD, off = wgid / NXCD; wgid = (xcd < r ? xcd * (q + 1) : r * (q + 1) + (xcd - r) * q) + off; }
    const int nig = WGM * nN, gid = wgid / nig, fm = gid * WGM, gsz = (nM - fm) < WGM ? (nM - fm) : WGM;
    pm = fm + ((wgid % nig) % gsz); pn = (wgid % nig) / gsz;
}
typedef int i32x8 __attribute__((ext_vector_type(8)));
typedef int i32x4 __attribute__((ext_vector_type(4)));
__device__ __forceinline__ i32x8 cat8(bf16x8 a, bf16x8 b) { const i32x4 x = __builtin_bit_cast(i32x4, a), y = __builtin_bit_cast(i32x4, b); return (i32x8){x[0], x[1], x[2], x[3], y[0], y[1], y[2], y[3]}; }
__device__ __forceinline__ unsigned cvt_pk_bf16(float lo, float hi) { unsigned r; asm volatile("v_cvt_pk_bf16_f32 %0, %1, %2" : "=v"(r) : "v"(lo), "v"(hi)); return r; }

template <class Epi, class Sched, bool F8 = false>
__device__ __forceinline__ void gemm_phase(LAS unsigned char* lds, const int K, const Sched& S, const Epi& E, const int ntiles = 0) {
    int tid_ = threadIdx.x; asm volatile("" : "+v"(tid_));
    const int tid = tid_, wid = __builtin_amdgcn_readfirstlane(tid >> 6), lane = tid & 63, wr = wid >> 2, wc = wid & 3, fr = lane & 15, fq = lane >> 4;
    const int nt = ntiles ? ntiles : K / BK;
    unsigned voffA[2], voffB[2];
#pragma unroll
    for (int i = 0; i < 2; ++i) { int R, C; stage_rc(tid * 16 + i * 8192, R, C); const int Rb = Epi::PERM ? ((R & ~31) + perm32(R & 31)) : R;
        voffA[i] = (unsigned)(R * K + C) * 2u; voffB[i] = (unsigned)(Rb * K + C) * 2u; }
    const size_t kstep = (size_t)(BK * 2);
    const size_t hstep = (size_t)HALF * K * 2;
    const unsigned ldsw = (unsigned)wid * 1024u;
    const int aoff = lds_byte(wr * 64 + fr, fq * 8), boff = lds_byte(wc * 32 + fr, fq * 8);
#define PG8_SA(b, h) (((b) * 2 + (h)) * HTB)
#define PG8_SB(b, h) ((4 + (b) * 2 + (h)) * HTB)
#define PG8_STAGE(bufoff, gbase, voff) do { _Pragma("unroll") for (int _i = 0; _i < 2; ++_i) \
        __builtin_amdgcn_global_load_lds((const unsigned*)((const char*)(gbase) + (voff)[_i]), (LAS unsigned*)(lds + (bufoff) + ldsw + _i * 8192), 16, 0, 0); } while (0)
#define PG8_LDA(dst, b, h) do { if (F8) { _Pragma("unroll") for (int m = 0; m < 4; ++m) { const i32x4 lo_ = *(const LAS i32x4*)(lds + PG8_SA(b, h) + aoff + m * 2048), hi_ = *(const LAS i32x4*)(lds + PG8_SA(b, h) + aoff + m * 2048 + 1024); dst##8[m] = __builtin_shufflevector(lo_, hi_, 0, 1, 2, 3, 4, 5, 6, 7); } } \
        else { _Pragma("unroll") for (int m = 0; m < 4; ++m) _Pragma("unroll") for (int k = 0; k < 2; ++k) dst[m][k] = *(const LAS bf16x8*)(lds + PG8_SA(b, h) + aoff + m * 2048 + k * 1024); } } while (0)
#define PG8_LDB(dst, b, h) do { if (F8) { _Pragma("unroll") for (int n = 0; n < 2; ++n) { const i32x4 lo_ = *(const LAS i32x4*)(lds + PG8_SB(b, h) + boff + n * 2048), hi_ = *(const LAS i32x4*)(lds + PG8_SB(b, h) + boff + n * 2048 + 1024); dst##8[n] = __builtin_shufflevector(lo_, hi_, 0, 1, 2, 3, 4, 5, 6, 7); } } \
        else { _Pragma("unroll") for (int n = 0; n < 2; ++n) _Pragma("unroll") for (int k = 0; k < 2; ++k) dst[n][k] = *(const LAS bf16x8*)(lds + PG8_SB(b, h) + boff + n * 2048 + k * 1024); } } while (0)
#define PG8_MMA(ai, bj, At, Bt) do { if (F8) { __builtin_amdgcn_s_setprio(1); _Pragma("unroll") for (int m = 0; m < 4; ++m) _Pragma("unroll") for (int n = 0; n < 2; ++n) \
        asm volatile("v_mfma_scale_f32_16x16x128_f8f6f4 %0, %1, %2, %0, %3, %3 op_sel_hi:[0,0,0]" : "+v"(acc[ai][bj][m][n]) : "v"(Bt##8[n]), "v"(At##8[m]), "v"(f8one)); __builtin_amdgcn_s_setprio(0); } else PG8_MMA_BF(ai, bj, At, Bt); } while (0)
#define PG8_MMA_BF(ai, bj, At, Bt) do { __builtin_amdgcn_s_setprio(1); _Pragma("unroll") for (int m = 0; m < 4; ++m) _Pragma("unroll") for (int n = 0; n < 2; ++n) _Pragma("unroll") for (int k = 0; k < 2; ++k) \
        acc[ai][bj][m][n] = __builtin_amdgcn_mfma_f32_16x16x32_bf16(Bt[n][k], At[m][k], acc[ai][bj][m][n], 0, 0, 0); __builtin_amdgcn_s_setprio(0); } while (0)
#define PG8_WAIT_V(n) asm volatile("s_waitcnt vmcnt(" #n ")" ::: "memory")
#define PG8_WAIT_L(n) asm volatile("s_waitcnt lgkmcnt(" #n ")" ::: "memory")
#define PG8_BAR __builtin_amdgcn_s_barrier()
#define PG8_SCHED __builtin_amdgcn_sched_barrier(0)
    Unit cur, nxt; int ui = 0;
    if (!S.next(0, cur)) return;
    f32x4 acc[2][2][4][2];
#pragma unroll
    for (int a = 0; a < 2; ++a)
#pragma unroll
        for (int b = 0; b < 2; ++b)
#pragma unroll
            for (int m = 0; m < 4; ++m)
#pragma unroll
                for (int n = 0; n < 2; ++n) acc[a][b][m][n] = (f32x4){0.f, 0.f, 0.f, 0.f};
    int f8one = 0x7f7f7f7f; asm volatile("" : "+v"(f8one));
    bf16x8 At[4][2], B0[2][2], B1[2][2]; i32x8 At8[4], B08[2], B18[2];
    const char* cA = cur.A; const char* cB = cur.B;
    PG8_STAGE(PG8_SB(0, 0), cB, voffB); PG8_STAGE(PG8_SB(0, 1), cB + hstep, voffB); PG8_STAGE(PG8_SA(0, 0), cA, voffA); PG8_STAGE(PG8_SA(0, 1), cA + hstep, voffA);
    if (wr == 1) PG8_BAR;
    PG8_WAIT_V(2); PG8_BAR;
    PG8_STAGE(PG8_SB(1, 0), cB + kstep, voffB); PG8_STAGE(PG8_SA(1, 0), cA + kstep, voffA); PG8_STAGE(PG8_SB(1, 1), cB + hstep + kstep, voffB);
    PG8_WAIT_V(6); PG8_BAR;
    for (;;) {
        const bool has_next = S.next(ui + 1, nxt);
        const char* nA = has_next ? nxt.A : cA; const char* nB = has_next ? nxt.B : cB;
        for (int t = 0; t < nt; t += 2) {
            const bool last = (t == nt - 2);
            const char* a1 = cA + (size_t)(t + 1) * kstep;
            const char* a2 = last ? nA : cA + (size_t)(t + 2) * kstep; const char* b2 = last ? nB : cB + (size_t)(t + 2) * kstep;
            const char* a3 = a2 + kstep; const char* b3 = b2 + kstep;
            PG8_LDB(B0, 0, 0); PG8_LDB(B1, 0, 1); PG8_SCHED; PG8_LDA(At, 0, 0); PG8_STAGE(PG8_SA(1, 1), a1 + hstep, voffA);
            PG8_WAIT_V(8); PG8_WAIT_L(0); PG8_BAR; PG8_MMA(0, 0, At, B0); PG8_MMA(0, 1, At, B1); PG8_BAR; PG8_SCHED;
            PG8_LDA(At, 0, 1); PG8_STAGE(PG8_SB(0, 0), b2, voffB); PG8_STAGE(PG8_SB(0, 1), b2 + hstep, voffB); PG8_STAGE(PG8_SA(0, 0), a2, voffA);
            PG8_WAIT_V(8); PG8_WAIT_L(0); PG8_BAR; PG8_MMA(1, 0, At, B0); PG8_MMA(1, 1, At, B1); PG8_BAR; PG8_SCHED;
            PG8_LDB(B0, 1, 0); PG8_LDB(B1, 1, 1); PG8_SCHED; PG8_LDA(At, 1, 0); PG8_STAGE(PG8_SA(0, 1), a2 + hstep, voffA);
            PG8_WAIT_V(8); PG8_WAIT_L(0); PG8_BAR; PG8_MMA(0, 0, At, B0); PG8_MMA(0, 1, At, B1); PG8_BAR; PG8_SCHED;
            PG8_LDA(At, 1, 1); PG8_STAGE(PG8_SB(1, 0), b3, voffB); PG8_STAGE(PG8_SB(1, 1), b3 + hstep, voffB); PG8_STAGE(PG8_SA(1, 0), a3, voffA);
            PG8_WAIT_V(8); PG8_WAIT_L(0); PG8_BAR; PG8_MMA(1, 0, At, B0); PG8_MMA(1, 1, At, B1); PG8_BAR; PG8_SCHED;
        }
        if (wr == 0) PG8_BAR;
        if (F8) asm volatile("s_nop 15\n\ts_nop 15" ::: "memory");
        const bool keep = E(acc, cur, wr, wc, fr, fq);
        if (!has_next) break;
        if (!keep) {
#pragma unroll
        for (int a = 0; a < 2; ++a)
#pragma unroll
            for (int b = 0; b < 2; ++b)
#pragma unroll
                for (int m = 0; m < 4; ++m)
#pragma unroll
                    for (int n = 0; n < 2; ++n) acc[a][b][m][n] = (f32x4){0.f, 0.f, 0.f, 0.f};
        }
        cur = nxt; cA = nA; cB = nB; ++ui;
        if (wr == 1) PG8_BAR;
    }
    PG8_WAIT_V(0);
    PG8_BAR;
#undef PG8_SA
#undef PG8_SB
#undef PG8_STAGE
#undef PG8_LDA
#undef PG8_LDB
#undef PG8_MMA
#undef PG8_MMA_BF
#undef PG8_WAIT_V
#undef PG8_WAIT_L
#undef PG8_BAR
#undef PG8_SCHED
}
}
struct Ctx {
    float* out; unsigned char* ws; unsigned* ctl; LAS unsigned char* lds; volatile LAS unsigned* misc;
    int tid, lane, wave, G, bid;
    __device__ __forceinline__ const float* in(int i) const { const unsigned lo = __builtin_amdgcn_readfirstlane(misc[64 + 2 * i]), hi = __builtin_amdgcn_readfirstlane(misc[65 + 2 * i]);
        return (const float*)(const __attribute__((address_space(1))) float*)(((unsigned long long)hi << 32) | lo); }
};
__device__ __forceinline__ float rstd_of(const u64* sumsq, int row) { return __builtin_amdgcn_rsqf((float)sumsq[row] * SS_UNFIX + RMS_EPS); }

struct EpiWin {
    static constexpr bool PERM = true;
    bf16* uT; bf16* qkvr; bf16* sg; const u64* sumsq;
    __device__ __forceinline__ bool operator()(f32x4 (&acc)[2][2][4][2], const pg8::Unit& u, int wr, int wc, int fr, int fq) const {
        using namespace pg8;
        if (u.kind == 0) {
            const int col0 = u.pn * BM + wc * 32 + 8 * fq;
            f32x4 rs[2][2];
#pragma unroll
            for (int bj = 0; bj < 2; ++bj)
#pragma unroll
                for (int n = 0; n < 2; ++n) { const int c = col0 + bj * HALF + 4 * n;
                    rs[bj][n] = (f32x4){rstd_of(sumsq, c), rstd_of(sumsq, c + 1), rstd_of(sumsq, c + 2), rstd_of(sumsq, c + 3)}; }
#pragma unroll
            for (int ai = 0; ai < 2; ++ai)
#pragma unroll
                for (int m = 0; m < 4; ++m) { bf16* rowp = uT + (size_t)(u.pm * BM + ai * HALF + wr * 64 + m * 16 + fr) * L + col0;
#pragma unroll
                    for (int bj = 0; bj < 2; ++bj) { const f32x4 v0 = acc[ai][bj][m][0] * rs[bj][0], v1 = acc[ai][bj][m][1] * rs[bj][1];
                        v4u w; w.x = cvt_pk_bf16(v0[0], v0[1]); w.y = cvt_pk_bf16(v0[2], v0[3]); w.z = cvt_pk_bf16(v1[0], v1[1]); w.w = cvt_pk_bf16(v1[2], v1[3]);
                        *(v4u*)(rowp + bj * HALF) = w; } }
        } else {
            const int mode = u.pn < 8 ? 0 : (u.pn < 12 ? 1 : 2);
            bf16* base = u.pn < 12 ? qkvr + u.pn * BM : sg + (u.pn - 12) * BM; const int ld = u.pn < 12 ? 3072 : 4096;
            const int col0 = wc * 32 + 8 * fq;
            float rsv[2][4];
#pragma unroll
            for (int ai = 0; ai < 2; ++ai)
#pragma unroll
                for (int m = 0; m < 4; ++m) rsv[ai][m] = rstd_of(sumsq, u.pm * BM + ai * HALF + wr * 64 + m * 16 + fr);
#pragma unroll
            for (int ai = 0; ai < 2; ++ai)
#pragma unroll
                for (int m = 0; m < 4; ++m) { const int row = u.pm * BM + ai * HALF + wr * 64 + m * 16 + fr; const float rs = rsv[ai][m];
                    bf16* rowp = base + (size_t)row * ld + col0;
#pragma unroll
                    for (int bj = 0; bj < 2; ++bj) { f32x4 v0 = acc[ai][bj][m][0] * rs, v1 = acc[ai][bj][m][1] * rs;
                        if (mode == 1) {
#pragma unroll
                            for (int j = 0; j < 4; ++j) { v0[j] = fsilu(v0[j]); v1[j] = fsilu(v1[j]); } }
                        if (mode == 2) {
#pragma unroll
                            for (int j = 0; j < 4; ++j) { v0[j] = fsigmoid(v0[j]); v1[j] = fsigmoid(v1[j]); } }
                        v4u w; w.x = cvt_pk_bf16(v0[0], v0[1]); w.y = cvt_pk_bf16(v0[2], v0[3]); w.z = cvt_pk_bf16(v1[0], v1[1]); w.w = cvt_pk_bf16(v1[2], v1[3]);
                        *(v4u*)(rowp + bj * HALF) = w; } }
        }
        return false;
    }
};
struct SchedWin {
    int G, c; const char* WtHy; const char* WtRest; const char* xb;
    __device__ __forceinline__ bool next(int i, pg8::Unit& u) const {
        const int Lw = i * G + c; if (Lw >= 32 * 40) return false;
        int pm, pn; pg8::tile_of(Lw, 32, 40, pm, pn); const size_t ts = (size_t)256 * D * 2;
        if (pn < 12) { u.A = WtHy + pn * ts; u.B = xb + pm * ts; u.pm = pn; u.pn = pm; u.kind = 0; }
        else { u.A = xb + pm * ts; u.B = WtRest + (pn - 12) * ts; u.pm = pm; u.pn = pn - 12; u.kind = 1; }
        return true;
    }
};
struct SchedGrid {
    int G, c, nM, nN; const char* A; const char* B; size_t ts;
    __device__ __forceinline__ bool next(int i, pg8::Unit& u) const {
        const int Lw = i * G + c; if (Lw >= nM * nN) return false;
        int pm, pn; pg8::tile_of(Lw, nM, nN, pm, pn); u.A = A + pm * ts; u.B = B + pn * ts; u.pm = pm; u.pn = pn; u.kind = 0; return true;
    }
};
struct EpiBranch {
    static constexpr bool PERM = true;
    const bf16* sg; bf16* mixed;
    __device__ __forceinline__ bool operator()(f32x4 (&acc)[2][2][4][2], const pg8::Unit& u, int wr, int wc, int fr, int fq) const {
        using namespace pg8;
        const int col0 = u.pn * BM + wc * 32 + 8 * fq;
        if (u.kind == 0) {
#pragma unroll
            for (int ai = 0; ai < 2; ++ai) { v4u ga[4][2], gb[4][2];
#pragma unroll
                for (int m = 0; m < 4; ++m)
#pragma unroll
                    for (int bj = 0; bj < 2; ++bj) { const size_t o = (size_t)(u.pm * BM + ai * HALF + wr * 64 + m * 16 + fr) * 4096 + col0 + bj * HALF; ga[m][bj] = *(const v4u*)(sg + o); gb[m][bj] = *(const v4u*)(sg + o + 2048); }
#pragma unroll
                for (int m = 0; m < 4; ++m)
#pragma unroll
                    for (int bj = 0; bj < 2; ++bj) { const v4u a4 = ga[m][bj], b4 = gb[m][bj];
                        const float a[8] = {bf2f(a4.x & 0xffffu), bf2f(a4.x >> 16), bf2f(a4.y & 0xffffu), bf2f(a4.y >> 16), bf2f(a4.z & 0xffffu), bf2f(a4.z >> 16), bf2f(a4.w & 0xffffu), bf2f(a4.w >> 16)};
                        const float b[8] = {bf2f(b4.x & 0xffffu), bf2f(b4.x >> 16), bf2f(b4.y & 0xffffu), bf2f(b4.y >> 16), bf2f(b4.z & 0xffffu), bf2f(b4.z >> 16), bf2f(b4.w & 0xffffu), bf2f(b4.w >> 16)};
#pragma unroll
                        for (int j = 0; j < 4; ++j) { acc[ai][bj][m][0][j] *= a[j] * __builtin_amdgcn_rcpf(b[j]); acc[ai][bj][m][1][j] *= a[4 + j] * __builtin_amdgcn_rcpf(b[4 + j]); } } }
            return true;
        }
#pragma unroll
        for (int ai = 0; ai < 2; ++ai) { v4u gb[4][2];
#pragma unroll
            for (int m = 0; m < 4; ++m)
#pragma unroll
                for (int bj = 0; bj < 2; ++bj) gb[m][bj] = *(const v4u*)(sg + (size_t)(u.pm * BM + ai * HALF + wr * 64 + m * 16 + fr) * 4096 + 2048 + col0 + bj * HALF);
#pragma unroll
            for (int m = 0; m < 4; ++m)
#pragma unroll
                for (int bj = 0; bj < 2; ++bj) { const v4u b4 = gb[m][bj];
                    const float b[8] = {bf2f(b4.x & 0xffffu), bf2f(b4.x >> 16), bf2f(b4.y & 0xffffu), bf2f(b4.y >> 16), bf2f(b4.z & 0xffffu), bf2f(b4.z >> 16), bf2f(b4.w & 0xffffu), bf2f(b4.w >> 16)};
                    f32x4 v0 = acc[ai][bj][m][0], v1 = acc[ai][bj][m][1];
#pragma unroll
                    for (int j = 0; j < 4; ++j) { v0[j] *= b[j]; v1[j] *= b[4 + j]; }
                    v4u w; w.x = cvt_pk_bf16(v0[0], v0[1]); w.y = cvt_pk_bf16(v0[2], v0[3]); w.z = cvt_pk_bf16(v1[0], v1[1]); w.w = cvt_pk_bf16(v1[2], v1[3]);
                    *(v4u*)(mixed + (size_t)(u.pm * BM + ai * HALF + wr * 64 + m * 16 + fr) * D + col0 + bj * HALF) = w; } }
        return false;
    }
};
struct SchedBranch {
    int G, c; const char* hy; const char* gla; const char* WaT; const char* WbT;
    __device__ __forceinline__ bool next(int i, pg8::Unit& u) const {
        const int Lw = (i >> 1) * G + c; if (Lw >= 32 * 8) return false;
        int pm, pn; pg8::tile_of(Lw, 32, 8, pm, pn); const size_t ts = (size_t)256 * 1024 * 2;
        u.pm = pm; u.pn = pn; u.kind = i & 1;
        if ((i & 1) == 0) { u.A = hy + pm * ts; u.B = WaT + pn * ts; } else { u.A = gla + pm * ts; u.B = WbT + pn * ts; }
        return true;
    }
};
template <int XO> struct EpiResid {
    static constexpr bool PERM = true;
    const float* base; float* xres; bf16* xb; u64* sumsq;
    __device__ __forceinline__ bool operator()(f32x4 (&acc)[2][2][4][2], const pg8::Unit& u, int wr, int wc, int fr, int fq) const {
        using namespace pg8;
        const int col0 = u.pn * BM + wc * 32 + 8 * fq;
#pragma unroll
        for (int ai = 0; ai < 2; ++ai) { f32x4 bv[4][2][2];
#pragma unroll
            for (int m = 0; m < 4; ++m)
#pragma unroll
                for (int bj = 0; bj < 2; ++bj)
#pragma unroll
                    for (int n = 0; n < 2; ++n) bv[m][bj][n] = *(const f32x4*)(base + (size_t)(u.pm * BM + ai * HALF + wr * 64 + m * 16 + fr) * D + col0 + bj * HALF + 4 * n);
            asm volatile("" ::: "memory");
#pragma unroll
            for (int m = 0; m < 4; ++m) { const int row = u.pm * BM + ai * HALF + wr * 64 + m * 16 + fr; const size_t off = (size_t)row * D + col0; float s = 0.f;
#pragma unroll
                for (int bj = 0; bj < 2; ++bj) { const size_t o = off + bj * HALF; const f32x4 v0 = bv[m][bj][0] + acc[ai][bj][m][0], v1 = bv[m][bj][1] + acc[ai][bj][m][1];
                    *(f32x4*)(xres + o) = v0; *(f32x4*)(xres + o + 4) = v1;
                    if (XO == 0) { v4u w; w.x = cvt_pk_bf16(v0[0], v0[1]); w.y = cvt_pk_bf16(v0[2], v0[3]); w.z = cvt_pk_bf16(v1[0], v1[1]); w.w = cvt_pk_bf16(v1[2], v1[3]); *(v4u*)(xb + o) = w; }
                    if (XO == 1) { *(v2u*)((unsigned char*)xb + o) = (v2u){f8pack4(v0[0] * F8_ASCALE, v0[1] * F8_ASCALE, v0[2] * F8_ASCALE, v0[3] * F8_ASCALE), f8pack4(v1[0] * F8_ASCALE, v1[1] * F8_ASCALE, v1[2] * F8_ASCALE, v1[3] * F8_ASCALE)}; }
                    s += (v0[0] * v0[0] + v0[1] * v0[1]) + (v0[2] * v0[2] + v0[3] * v0[3]); s += (v1[0] * v1[0] + v1[1] * v1[1]) + (v1[2] * v1[2] + v1[3] * v1[3]); }
                s += __shfl_xor(s, 16); s += __shfl_xor(s, 32);
                if (fq == 0) atomicAdd(sumsq + row, (u64)(s * SS_FIX)); } }
        return false;
    }
};
template <bool O8> struct EpiSwigluT {
    static constexpr bool PERM = true;
    bf16* act; const u64* sumsq; const float* rowscale; float mul;
    __device__ __forceinline__ bool operator()(f32x4 (&acc)[2][2][4][2], const pg8::Unit& u, int wr, int wc, int fr, int fq) const {
        using namespace pg8;
        const int col0 = u.pn * HALF + wc * 32 + 8 * fq;
        float rsv[2][4];
        if (sumsq) {
#pragma unroll
            for (int ai = 0; ai < 2; ++ai)
#pragma unroll
                for (int m = 0; m < 4; ++m) rsv[ai][m] = rstd_of(sumsq, u.pm * BM + ai * HALF + wr * 64 + m * 16 + fr) * mul;
        } else {
#pragma unroll
            for (int ai = 0; ai < 2; ++ai)
#pragma unroll
                for (int m = 0; m < 4; ++m) rsv[ai][m] = rowscale[u.pm * BM + ai * HALF + wr * 64 + m * 16 + fr];
        }
#pragma unroll
        for (int ai = 0; ai < 2; ++ai)
#pragma unroll
            for (int m = 0; m < 4; ++m) { const int row = u.pm * BM + ai * HALF + wr * 64 + m * 16 + fr; const float rs = rsv[ai][m];
                float o[8];
#pragma unroll
                for (int n = 0; n < 2; ++n)
#pragma unroll
                    for (int j = 0; j < 4; ++j) { const float g = acc[ai][0][m][n][j] * rs, up = acc[ai][1][m][n][j] * rs; o[4 * n + j] = fsilu(g) * up; }
                v4u w; w.x = cvt_pk_bf16(o[0], o[1]); w.y = cvt_pk_bf16(o[2], o[3]); w.z = cvt_pk_bf16(o[4], o[5]); w.w = cvt_pk_bf16(o[6], o[7]);
                if (O8) *(v2u*)((unsigned char*)act + (size_t)row * FF + col0) = (v2u){f8pack4(o[0] * F8_ACTSCALE, o[1] * F8_ACTSCALE, o[2] * F8_ACTSCALE, o[3] * F8_ACTSCALE), f8pack4(o[4] * F8_ACTSCALE, o[5] * F8_ACTSCALE, o[6] * F8_ACTSCALE, o[7] * F8_ACTSCALE)};
                else *(v4u*)(act + (size_t)row * FF + col0) = w; }
        return false;
    }
};
typedef EpiSwigluT<false> EpiSwiglu;
struct EpiMoeDown {
    static constexpr bool PERM = true;
    bf16* ys; const float* rowgate;
    __device__ __forceinline__ bool operator()(f32x4 (&acc)[2][2][4][2], const pg8::Unit& u, int wr, int wc, int fr, int fq) const {
        using namespace pg8;
        const int col0 = u.pn * BM + wc * 32 + 8 * fq;
        float gv[2][4];
#pragma unroll
        for (int ai = 0; ai < 2; ++ai)
#pragma unroll
            for (int m = 0; m < 4; ++m) gv[ai][m] = rowgate[u.pm * BM + ai * HALF + wr * 64 + m * 16 + fr];
#pragma unroll
        for (int ai = 0; ai < 2; ++ai)
#pragma unroll
            for (int m = 0; m < 4; ++m) { const int row = u.pm * BM + ai * HALF + wr * 64 + m * 16 + fr; const float g = gv[ai][m];
#pragma unroll
                for (int bj = 0; bj < 2; ++bj) { const f32x4 v0 = acc[ai][bj][m][0] * g, v1 = acc[ai][bj][m][1] * g;
                    v4u w; w.x = cvt_pk_bf16(v0[0], v0[1]); w.y = cvt_pk_bf16(v0[2], v0[3]); w.z = cvt_pk_bf16(v1[0], v1[1]); w.w = cvt_pk_bf16(v1[2], v1[3]);
                    *(v4u*)(ys + (size_t)row * D + col0 + bj * HALF) = w; } }
        return false;
    }
};
struct SchedMoe {
    int G, c, ncol, limit; const char* A; const char* W; size_t ts, wstride; volatile LAS unsigned* misc;
    __device__ __forceinline__ bool next(int i, pg8::Unit& u) const {
        int Lw = i * G + c; if (Lw >= limit) return false;
#pragma unroll 1
        for (int e = 0; e < NE; ++e) { const int nt = (int)misc[16 + e], nu = nt * ncol;
            if (Lw < nu) { const int pn = Lw / nt, rt = Lw - pn * nt, tile = (int)misc[24 + e] + rt;
                u.A = A + (size_t)tile * ts; u.B = W + (size_t)e * wstride + (size_t)pn * ts; u.pm = tile; u.pn = pn; u.kind = e; return true; }
            Lw -= nu; }
        return false;
    }
};
__device__ __forceinline__ int moe_split_tiles(int S, int slice) { return S == 4 ? ((slice & 1) ? 10 : 12) : 22; }
struct SchedMoeSplit {
    int c; const char* A; const char* W; size_t ts, wstride; volatile LAS unsigned* misc;
    __device__ __forceinline__ bool next(int i, pg8::Unit& u) const {
        const int S = (int)misc[33], urem = (int)misc[34]; if (i > 0 || c >= urem * S) return false;
        const int uidx = c / S, slice = c - uidx * S; int Lw = (int)misc[32] + uidx;
#pragma unroll 1
        for (int e = 0; e < NE; ++e) { const int nt = (int)misc[16 + e], nu = nt * 8;
            if (Lw < nu) { const int pn = Lw / nt, rt = Lw - pn * nt, tile = (int)misc[24 + e] + rt; const size_t ko = (size_t)(S == 4 ? 22 * (slice >> 1) + 12 * (slice & 1) : 22 * slice) * 128;
                u.A = A + (size_t)tile * ts + ko; u.B = W + (size_t)e * wstride + (size_t)pn * ts + ko; u.pm = c; u.pn = tile; u.kind = e; return true; }
            Lw -= nu; }
        return false;
    }
};
struct EpiMoeDownSplit {
    static constexpr bool PERM = false;
    float* slab; const float* rowgate;
    __device__ __forceinline__ bool operator()(f32x4 (&acc)[2][2][4][2], const pg8::Unit& u, int wr, int wc, int fr, int fq) const {
        using namespace pg8;
        float* base = slab + (size_t)u.pm * 65536 + wc * 32 + 4 * fq;
#pragma unroll
        for (int ai = 0; ai < 2; ++ai)
#pragma unroll
            for (int m = 0; m < 4; ++m) { const int lr = ai * HALF + wr * 64 + m * 16 + fr; const float g = rowgate[u.pn * BM + lr];
#pragma unroll
                for (int bj = 0; bj < 2; ++bj)
#pragma unroll
                    for (int n = 0; n < 2; ++n) *(f32x4*)(base + lr * 256 + bj * HALF + n * 16) = acc[ai][bj][m][n] * g; }
        return false;
    }
};
struct EpiBf16Plain {
    static constexpr bool PERM = true;
    bf16* C; int ldc;
    __device__ __forceinline__ bool operator()(f32x4 (&acc)[2][2][4][2], const pg8::Unit& u, int wr, int wc, int fr, int fq) const {
        using namespace pg8;
        const int col0 = u.pn * BM + wc * 32 + 8 * fq;
#pragma unroll
        for (int ai = 0; ai < 2; ++ai)
#pragma unroll
            for (int m = 0; m < 4; ++m) { bf16* rowp = C + (size_t)(u.pm * BM + ai * HALF + wr * 64 + m * 16 + fr) * ldc + col0;
#pragma unroll
                for (int bj = 0; bj < 2; ++bj) { const f32x4 v0 = acc[ai][bj][m][0], v1 = acc[ai][bj][m][1];
                    v4u w; w.x = cvt_pk_bf16(v0[0], v0[1]); w.y = cvt_pk_bf16(v0[2], v0[3]); w.z = cvt_pk_bf16(v1[0], v1[1]); w.w = cvt_pk_bf16(v1[2], v1[3]);
                    *(v4u*)(rowp + bj * HALF) = w; } }
        return false;
    }
};
struct EpiF32 {
    static constexpr bool PERM = false;
    float* C; int ldc;
    __device__ __forceinline__ bool operator()(f32x4 (&acc)[2][2][4][2], const pg8::Unit& u, int wr, int wc, int fr, int fq) const {
        using namespace pg8;
        const int col0 = u.pn * BM + wc * 32 + 4 * fq;
#pragma unroll
        for (int ai = 0; ai < 2; ++ai)
#pragma unroll
            for (int m = 0; m < 4; ++m) { float* rowp = C + (size_t)(u.pm * BM + ai * HALF + wr * 64 + m * 16 + fr) * ldc + col0;
#pragma unroll
                for (int bj = 0; bj < 2; ++bj)
#pragma unroll
                    for (int n = 0; n < 2; ++n) *(f32x4*)(rowp + bj * HALF + n * 16) = acc[ai][bj][m][n]; }
        return false;
    }
};
struct TrItem { const float* W; bf16* dst; const float* kscale; int N, ldk, k0, f8; };
__device__ __forceinline__ void tr_load(const TrItem& d, int lane, f32x4 (&v)[16]) {
    const int kk = lane >> 4, q = lane & 15;
#pragma unroll
    for (int i = 0; i < 16; ++i) v[i] = __builtin_nontemporal_load((const f32x4*)(d.W + (size_t)(d.k0 + 4 * i + kk) * d.N + 4 * q));
}
typedef short s16x4 __attribute__((ext_vector_type(4)));
__device__ __forceinline__ void tr_store_f8(const TrItem& d, int lane, const f32x4 (&v)[16], LAS float* scr_) {
    LAS unsigned char* scr = (LAS unsigned char*)scr_;
    const int kk = lane >> 4, q = lane & 15;
#pragma unroll
    for (int i = 0; i < 16; ++i) { const int k = 4 * i + kk; const float s = (d.kscale ? d.kscale[d.k0 + k] : 1.0f) * F8_WSCALE;
        v2u w; w.x = pg8::cvt_pk_bf16(v[i][0] * s, v[i][1] * s); w.y = pg8::cvt_pk_bf16(v[i][2] * s, v[i][3] * s); *(LAS v2u*)(scr + k * 160 + q * 8) = w; }
    LDS_WAIT(); asm volatile("" ::: "memory");
    const int g = lane >> 4, i = lane & 15, qq = i >> 2, p = i & 3, par = g & 1;
#pragma unroll
    for (int nb = 0; nb < 4; ++nb) { v2u r[4];
#pragma unroll
        for (int t = 0; t < 4; ++t) r[t] = __builtin_bit_cast(v2u, __builtin_amdgcn_ds_read_tr16_b64_v4i16((LAS s16x4*)(scr + (16 * g + 4 * (t ^ par) + qq) * 160 + (16 * nb + 4 * p) * 2)));
        unsigned o[4];
#pragma unroll
        for (int h = 0; h < 2; ++h) { const v2u lo = par ? r[2 * h + 1] : r[2 * h], hi = par ? r[2 * h] : r[2 * h + 1];
            int w0 = 0, w1 = 0;
            w0 = __builtin_amdgcn_cvt_pk_fp8_f32(bf2f(lo.x & 0xffffu), bf2f(lo.x >> 16), w0, false); w0 = __builtin_amdgcn_cvt_pk_fp8_f32(bf2f(lo.y & 0xffffu), bf2f(lo.y >> 16), w0, true);
            w1 = __builtin_amdgcn_cvt_pk_fp8_f32(bf2f(hi.x & 0xffffu), bf2f(hi.x >> 16), w1, false); w1 = __builtin_amdgcn_cvt_pk_fp8_f32(bf2f(hi.y & 0xffffu), bf2f(hi.y >> 16), w1, true);
            o[2 * h] = (unsigned)w0; o[2 * h + 1] = (unsigned)w1; }
        *(v4u*)((unsigned char*)d.dst + (size_t)(16 * nb + i) * d.ldk + d.k0 + 16 * g) = (v4u){o[0], o[1], o[2], o[3]}; }
    LDS_WAIT(); asm volatile("" ::: "memory");
}
__device__ __forceinline__ void tr_store(const TrItem& d, int lane, const f32x4 (&v)[16], LAS float* scr) {
    if (d.f8) { tr_store_f8(d, lane, v, scr); return; }
    const int kk = lane >> 4, q = lane & 15;
#pragma unroll
    for (int i = 0; i < 16; ++i) { const int k = 4 * i + kk; const float s = d.kscale ? d.kscale[d.k0 + k] : 1.0f;
        scr[k * 65 + 4 * q + 0] = v[i][0] * s; scr[k * 65 + 4 * q + 1] = v[i][1] * s; scr[k * 65 + 4 * q + 2] = v[i][2] * s; scr[k * 65 + 4 * q + 3] = v[i][3] * s; }
    LDS_WAIT(); asm volatile("" ::: "memory");
    const int nn = lane & 7, c = lane >> 3;
#pragma unroll
    for (int it = 0; it < 8; ++it) { const int n = 8 * it + nn; const LAS float* s = scr + (8 * c) * 65 + n;
        v4u o; o.x = pk2(s[0 * 65], s[1 * 65]); o.y = pk2(s[2 * 65], s[3 * 65]); o.z = pk2(s[4 * 65], s[5 * 65]); o.w = pk2(s[6 * 65], s[7 * 65]);
        if (d.f8) { int lo = 0, hi = 0;
            lo = __builtin_amdgcn_cvt_pk_fp8_f32(s[0 * 65] * F8_WSCALE, s[1 * 65] * F8_WSCALE, lo, false); lo = __builtin_amdgcn_cvt_pk_fp8_f32(s[2 * 65] * F8_WSCALE, s[3 * 65] * F8_WSCALE, lo, true);
            hi = __builtin_amdgcn_cvt_pk_fp8_f32(s[4 * 65] * F8_WSCALE, s[5 * 65] * F8_WSCALE, hi, false); hi = __builtin_amdgcn_cvt_pk_fp8_f32(s[6 * 65] * F8_WSCALE, s[7 * 65] * F8_WSCALE, hi, true);
            *(v2u*)((unsigned char*)d.dst + (size_t)n * d.ldk + d.k0 + 8 * c) = (v2u){(unsigned)lo, (unsigned)hi}; }
        else *(v4u*)(d.dst + (size_t)n * d.ldk + d.k0 + 8 * c) = o; }
    LDS_WAIT(); asm volatile("" ::: "memory");
}
constexpr int IT_WIN = 2 * 32 * 160, IT_WAB = 2 * 2 * 16 * 32, IT_WOUT = 2 * 32 * 32, IT_GU = 9 * 2 * 32 * 88, IT_DN = 9 * 88 * 32;
constexpr int IT_TOTAL = IT_WIN + IT_WAB + IT_WOUT + IT_GU + IT_DN;
__device__ __forceinline__ void item_desc(const Ctx& X, int r, TrItem& d) {
    unsigned char* ws = X.ws;
    if (r < IT_WIN) {
        const int l = r / (32 * 160); r -= l * 32 * 160; const int kt = r / 160, nt = r % 160;
        const float* W = X.in(I_W_IN) + (size_t)l * D * PIN; int col;
        if (nt < 48) { col = 64 * nt; d.dst = (bf16*)(ws + WS_W + l * W_LAYER + W_HY) + (size_t)(64 * nt) * D; }
        else if (nt < 96) { col = 64 * nt; d.dst = (bf16*)(ws + WS_W + l * W_LAYER + W_REST) + (size_t)(64 * (nt - 48)) * D; }
        else { col = C_GA + 64 * (nt - 96); d.dst = (bf16*)(ws + WS_W + l * W_LAYER + W_REST) + (size_t)(3072 + 64 * (nt - 96)) * D; }
        d.W = W + col; d.N = PIN; d.ldk = D; d.k0 = 64 * kt; d.kscale = X.in(I_NORM_MIX) + l * D; d.f8 = 0; return; }
    r -= IT_WIN;
    if (r < IT_WAB) {
        const int l = r / (2 * 16 * 32); r -= l * 2 * 16 * 32; const int ab = r / (16 * 32); r -= ab * 16 * 32; const int kt = r / 32, nt = r % 32;
        d.W = X.in(ab ? I_WB : I_WA) + (size_t)l * 1024 * D + 64 * nt; d.dst = (bf16*)(ws + WS_W + l * W_LAYER + (ab ? W_B : W_A)) + (size_t)(64 * nt) * 1024;
        d.N = D; d.ldk = 1024; d.k0 = 64 * kt; d.kscale = nullptr; d.f8 = 0; return; }
    r -= IT_WAB;
    if (r < IT_WOUT) {
        const int l = r / (32 * 32); r -= l * 32 * 32; const int kt = r / 32, nt = r % 32;
        d.W = X.in(I_WOUT) + (size_t)l * D * D + 64 * nt; d.dst = (bf16*)(ws + WS_W + l * W_LAYER + W_O) + (size_t)(64 * nt) * D; d.N = D; d.ldk = D; d.k0 = 64 * kt; d.kscale = nullptr; d.f8 = 0; return; }
    r -= IT_WOUT;
    if (r < IT_GU) {
        const int f = r / (2 * 32 * 88); r -= f * 2 * 32 * 88; const int gu = r / (32 * 88); r -= gu * 32 * 88; const int kt = r / 88, nt = r % 88;
        const float* W = f == 0 ? X.in(gu ? I_DWU : I_DWG) : X.in(gu ? I_MWU : I_MWG) + (size_t)(f - 1) * D * FF;
        const int n0 = 64 * nt, drow = 256 * (n0 >> 7) + 128 * gu + (n0 & 127);
        d.W = W + n0; d.N = FF; d.ldk = D; d.k0 = 64 * kt;
        d.dst = (bf16*)(ws + WS_WFF + (size_t)f * W_FFN + W_GU + (size_t)drow * D); d.kscale = f == 0 ? X.in(I_NORM_FFN) : nullptr; d.f8 = 1;
        return; }
    r -= IT_GU;
    {
        const int f = r / (88 * 32); r -= f * 88 * 32; const int kt = r / 32, nt = r % 32;
        const float* W = f == 0 ? X.in(I_DWD) : X.in(I_MWD) + (size_t)(f - 1) * FF * D;
        d.W = W + 64 * nt; d.N = D; d.ldk = FF; d.k0 = 64 * kt; d.kscale = nullptr;
        d.f8 = f != 0; d.dst = (bf16*)(ws + WS_WFF + (size_t)f * W_FFN + W_DT + (size_t)(64 * nt) * FF * (f == 0 ? 2 : 1)); }
}
__device__ __forceinline__ void p0_weights(const Ctx& X) {
    LAS float* scr = (LAS float*)(X.lds + X.wave * 16640);
    const int gw = X.bid * 8 + X.wave, NGW = X.G * 8;
    if (gw >= IT_TOTAL) return;
    const int last = gw + ((IT_TOTAL - 1 - gw) / NGW) * NGW;
    TrItem da, db; f32x4 va[16], vb[16];
    item_desc(X, gw, da); tr_load(da, X.lane, va);
#pragma unroll 1
    for (int it = gw; ; it += 2 * NGW) {
        { const int nx = it + NGW; item_desc(X, nx < last ? nx : last, db); tr_load(db, X.lane, vb); }
        tr_store(da, X.lane, va, scr);
        if (it + NGW > last) break;
        { const int nx = it + 2 * NGW; item_desc(X, nx < last ? nx : last, da); tr_load(da, X.lane, va); }
        tr_store(db, X.lane, vb, scr);
        if (it + 2 * NGW > last) break;
    }
}
template <int PART> __device__ __forceinline__ void p0_misc(const Ctx& X) {
    unsigned char* ws = X.ws; const int gt = X.bid * 512 + X.tid, NGT = X.G * 512;
    if (PART == 1) {
    { const float* win = X.in(I_W_IN); const float* nm = X.in(I_NORM_MIX);
    for (int i = gt; i < 2 * 32 * D; i += NGT) { const int l = i / (32 * D), j = (i / D) % 32, k = i % D;
        ((bf16*)(ws + WS_W + l * W_LAYER + W_LR))[(size_t)j * D + k] = (bf16)f2bf(win[(size_t)l * D * PIN + (size_t)k * PIN + C_LR + j] * nm[l * D + k]); } }
    }
    if (PART == 0) {
    const float* fw4 = X.in(I_FW4);
    for (int i = gt; i < 2 * 32 * 4096; i += NGT) { const int c = i % 4096, q = (i / 4096) % 32, l = i / (32 * 4096);
        v4u o = (v4u){0u, 0u, 0u, 0u};
        if (q < 8) { const float* w = fw4 + (size_t)l * 64 * 4096 + (size_t)(8 * q) * 4096 + c;
            o.x = pk2(w[0], w[4096]); o.y = pk2(w[2 * 4096], w[3 * 4096]); o.z = pk2(w[4 * 4096], w[5 * 4096]); o.w = pk2(w[6 * 4096], w[7 * 4096]); }
        *(v4u*)((bf16*)(ws + WS_W4T) + ((size_t)l * 4096 + c) * 256 + 8 * q) = o; }
    }
    if (PART == 1) {
    for (int i = gt; i < NFFT; i += NGT) { float s, c; sincospif((float)i * (1.0f / 8192.0f), &s, &c); ((f32x2*)(ws + WS_TW))[i] = (f32x2){c, -s}; }
    { const int gw = X.bid * 8 + X.wave, NGW = X.G * 8; u64* sumsq = (u64*)(X.ctl + CW_SUMSQ);
      const float* xin = X.in(I_X);
      for (int m = gw; m < L; m += NGW) { const f32x4* xr = (const f32x4*)(xin + (size_t)m * D) + X.lane; v2u* o8 = (v2u*)((bf16*)(ws + WS_XB) + (size_t)m * D) + X.lane; float s = 0.f;
#pragma unroll
          for (int j = 0; j < 8; ++j) { const f32x4 v = xr[64 * j]; s += (v[0] * v[0] + v[1] * v[1]) + (v[2] * v[2] + v[3] * v[3]); v2u w; w.x = pk2(v[0], v[1]); w.y = pk2(v[2], v[3]); o8[64 * j] = w; }
          s = wave_sum(s); if (X.lane == 0) sumsq[m] = (u64)(s * SS_FIX); } }
    }
    if (PART == 0) {
    { const int gw = X.bid * 8 + X.wave, NGW = X.G * 8; LAS float* zs = (LAS float*)(X.lds + 140 * 1024) + X.wave * 64;
      const float* fw1 = X.in(I_FW1); const float* fw2 = X.in(I_FW2); const float* fw3 = X.in(I_FW3); const float* fb1 = X.in(I_FB1); const float* fb2 = X.in(I_FB2); const float* fb3 = X.in(I_FB3);
      const float* ff1 = X.in(I_FF1); const float* ff2 = X.in(I_FF2); const float* ff3 = X.in(I_FF3);
#pragma unroll 1
      for (int l = 0; l < 2; ++l) { const int j = X.lane;
        float w1[33], w2[64], w3[64];
#pragma unroll
        for (int i = 0; i < 33; ++i) w1[i] = fw1[(size_t)l * 33 * 64 + i * 64 + j];
#pragma unroll
        for (int i = 0; i < 64; ++i) { w2[i] = fw2[(size_t)l * 64 * 64 + i * 64 + j]; w3[i] = fw3[(size_t)l * 64 * 64 + i * 64 + j]; }
        const float c1 = fb1[l * 64 + j], c2 = fb2[l * 64 + j], c3 = fb3[l * 64 + j], q1 = ff1[l * 64 + j], q2 = ff2[l * 64 + j], q3 = ff3[l * 64 + j];
#pragma unroll 1
        for (int t = gw; t < L; t += NGW) {
          { const float tn = (float)t / (float)(L - 1), om = 6.283185307179586f * (float)t / (float)L; float z = 0.f;
            if (j == 0) z = tn;
            else if (j <= 32) { const int b = (j - 1) & 15; const float band = 1e-4f + (float)b * ((15.0f - 1e-4f) / 15.0f); const float a = band * om, rv = a * 0.15915494309189535f;
                z = j <= 16 ? fcos_rev(rv) : -fsin_rev(rv); }
            zs[j] = z; }
          LDS_WAIT(); asm volatile("" ::: "memory");
          float a = c1;
#pragma unroll
          for (int i = 0; i < 32; i += 4) { const f32x4 z4 = *(const LAS f32x4*)(zs + i); a += z4[0] * w1[i]; a += z4[1] * w1[i + 1]; a += z4[2] * w1[i + 2]; a += z4[3] * w1[i + 3]; }
          a += zs[32] * w1[32];
          float h = fsin(q1 * a);
          LDS_WAIT(); asm volatile("" ::: "memory"); zs[j] = h; LDS_WAIT(); asm volatile("" ::: "memory");
          a = c2;
#pragma unroll
          for (int i = 0; i < 64; i += 4) { const f32x4 z4 = *(const LAS f32x4*)(zs + i); a += z4[0] * w2[i]; a += z4[1] * w2[i + 1]; a += z4[2] * w2[i + 2]; a += z4[3] * w2[i + 3]; }
          h = fsin(q2 * a);
          LDS_WAIT(); asm volatile("" ::: "memory"); zs[j] = h; LDS_WAIT(); asm volatile("" ::: "memory");
          a = c3;
#pragma unroll
          for (int i = 0; i < 64; i += 4) { const f32x4 z4 = *(const LAS f32x4*)(zs + i); a += z4[0] * w3[i]; a += z4[1] * w3[i + 1]; a += z4[2] * w3[i + 2]; a += z4[3] * w3[i + 3]; }
          h = fsin(q3 * a);
          LDS_WAIT(); asm volatile("" ::: "memory");
          bf16* o = (bf16*)(ws + WS_H3B) + ((size_t)l * L + t) * 256; o[j] = (bf16)f2bf(h); o[64 + j] = 0; o[128 + j] = 0; o[192 + j] = 0; } } }
    }
}
#ifdef FFT_HOST
#define FFT_HD inline
#define FFT_LAS
typedef struct { float x, y; } cpxv;
static inline float FADD(float a, float b) { return a + b; }
static inline float FSUB(float a, float b) { return a - b; }
static inline float FMUL(float a, float b) { return a * b; }
static inline float FFMA(float a, float b, float c) { return a * b + c; }
static inline float FFMS(float a, float b, float c) { return a * b - c; }
static inline float FNMA(float a, float b, float c) { return c - a * b; }
#else
#define FFT_HD __device__ __forceinline__
#define FFT_LAS LAS
typedef float cpxv __attribute__((ext_vector_type(2)));
__device__ __forceinline__ float FADD(float a, float b) { float r; asm("v_add_f32 %0, %1, %2" : "=v"(r) : "v"(a), "v"(b)); return r; }
__device__ __forceinline__ float FSUB(float a, float b) { float r; asm("v_sub_f32 %0, %1, %2" : "=v"(r) : "v"(a), "v"(b)); return r; }
__device__ __forceinline__ float FMUL(float a, float b) { float r; asm("v_mul_f32 %0, %1, %2" : "=v"(r) : "v"(a), "v"(b)); return r; }
__device__ __forceinline__ float FFMA(float a, float b, float c) { float r; asm("v_fma_f32 %0, %1, %2, %3" : "=v"(r) : "v"(a), "v"(b), "v"(c)); return r; }
__device__ __forceinline__ float FFMS(float a, float b, float c) { float r; asm("v_fma_f32 %0, %1, %2, -%3" : "=v"(r) : "v"(a), "v"(b), "v"(c)); return r; }
__device__ __forceinline__ float FNMA(float a, float b, float c) { float r; asm("v_fma_f32 %0, -%1, %2, %3" : "=v"(r) : "v"(a), "v"(b), "v"(c)); return r; }
#endif
struct cpx { float x, y; };
FFT_HD cpx cmul(cpx a, cpx b) { cpx r; r.x = FFMS(a.x, b.x, FMUL(a.y, b.y)); r.y = FFMA(a.x, b.y, FMUL(a.y, b.x)); return r; }
FFT_HD cpx cmulc(cpx a, cpx b) { cpx r; r.x = FFMA(a.x, b.x, FMUL(a.y, b.y)); r.y = FFMS(a.y, b.x, FMUL(a.x, b.y)); return r; }
FFT_HD cpx cadd(cpx a, cpx b) { cpx r; r.x = FADD(a.x, b.x); r.y = FADD(a.y, b.y); return r; }
FFT_HD cpx csub(cpx a, cpx b) { cpx r; r.x = FSUB(a.x, b.x); r.y = FSUB(a.y, b.y); return r; }
FFT_HD cpx cconj(cpx a) { cpx r; r.x = a.x; r.y = -a.y; return r; }
FFT_HD cpx ldz(const FFT_LAS cpxv* Z, int i) { const cpxv v = Z[i]; cpx r; r.x = v.x; r.y = v.y; return r; }
FFT_HD void stz(FFT_LAS cpxv* Z, int i, cpx a) { cpxv v; v.x = a.x; v.y = a.y; Z[i] = v; }
template <bool INV> FFT_HD void bfly_rot(cpx a, cpx b, cpx& p, cpx& m) {
    if (!INV) { p.x = FADD(a.x, b.y); p.y = FSUB(a.y, b.x); m.x = FSUB(a.x, b.y); m.y = FADD(a.y, b.x); }
    else      { p.x = FSUB(a.x, b.y); p.y = FADD(a.y, b.x); m.x = FADD(a.x, b.y); m.y = FSUB(a.y, b.x); }
}
template <bool INV> FFT_HD void dft4(cpx& x0, cpx& x1, cpx& x2, cpx& x3) {
    const cpx a = cadd(x0, x2), b = csub(x0, x2), c = cadd(x1, x3), d = csub(x1, x3);
    x0 = cadd(a, c); x2 = csub(a, c); bfly_rot<INV>(b, d, x1, x3);
}
template <bool INV> FFT_HD cpx mul_w8(cpx a) { const float h = 0.70710678118654752440f; cpx r;
    if (!INV) { r.x = FMUL(h, FADD(a.x, a.y)); r.y = FMUL(h, FSUB(a.y, a.x)); } else { r.x = FMUL(h, FSUB(a.x, a.y)); r.y = FMUL(h, FADD(a.x, a.y)); } return r; }
template <bool INV> FFT_HD cpx mul_w8_3(cpx a) { const float h = 0.70710678118654752440f; cpx r;
    if (!INV) { r.x = FMUL(h, FSUB(a.y, a.x)); r.y = FMUL(-h, FADD(a.x, a.y)); } else { r.x = FMUL(-h, FADD(a.x, a.y)); r.y = FMUL(h, FSUB(a.x, a.y)); } return r; }
template <bool INV> FFT_HD cpx mul_mi(cpx a) { cpx r; if (!INV) { r.x = a.y; r.y = -a.x; } else { r.x = -a.y; r.y = a.x; } return r; }
template <bool INV> FFT_HD cpx twc(float c, float s) { cpx r; r.x = c; r.y = INV ? s : -s; return r; }
template <bool INV> FFT_HD void dft8(cpx (&x)[8]) {
    dft4<INV>(x[0], x[2], x[4], x[6]);
    dft4<INV>(x[1], x[3], x[5], x[7]);
    const cpx o1 = mul_w8<INV>(x[3]), o3 = mul_w8_3<INV>(x[7]);
    const cpx e0 = x[0], e1 = x[2], e2 = x[4], e3 = x[6], o0 = x[1], o2 = x[5];
    x[0] = cadd(e0, o0); x[4] = csub(e0, o0); x[1] = cadd(e1, o1); x[5] = csub(e1, o1);
    bfly_rot<INV>(e2, o2, x[2], x[6]);
    x[3] = cadd(e3, o3); x[7] = csub(e3, o3);
}
template <bool INV> FFT_HD void dft16(cpx (&x)[16]) {
    dft4<INV>(x[0], x[4], x[8], x[12]); dft4<INV>(x[1], x[5], x[9], x[13]); dft4<INV>(x[2], x[6], x[10], x[14]); dft4<INV>(x[3], x[7], x[11], x[15]);
    const float c1 = 0.92387953251128675613f, s1 = 0.38268343236508977173f;
    x[5] = cmul(x[5], twc<INV>(c1, s1));
    x[9] = mul_w8<INV>(x[9]);
    x[13] = cmul(x[13], twc<INV>(s1, c1));
    x[6] = mul_w8<INV>(x[6]);
    x[10] = mul_mi<INV>(x[10]);
    x[14] = mul_w8_3<INV>(x[14]);
    x[7] = cmul(x[7], twc<INV>(s1, c1));
    x[11] = mul_w8_3<INV>(x[11]);
    x[15] = cmul(x[15], twc<INV>(-c1, -s1));
    dft4<INV>(x[0], x[1], x[2], x[3]); dft4<INV>(x[4], x[5], x[6], x[7]); dft4<INV>(x[8], x[9], x[10], x[11]); dft4<INV>(x[12], x[13], x[14], x[15]);
    cpx t;
#define FFT_SW(a, b) t = x[a]; x[a] = x[b]; x[b] = t;
    FFT_SW(1, 4) FFT_SW(2, 8) FFT_SW(3, 12) FFT_SW(6, 9) FFT_SW(7, 13) FFT_SW(11, 14)
#undef FFT_SW
}
constexpr int FFT_P = 129;
FFT_HD int kmap(int p) { return (p >> 3) + 16 * (p & 7); }
FFT_HD int kinv(int k) { return 8 * (k & 15) + (k >> 4); }
constexpr int FFT_TW1 = 128 * FFT_P, FFT_TWS = FFT_TW1 + 2048, FFT_TWA = FFT_TWS + 128;
template <bool INV, int DIM> FFT_HD void pass16(FFT_LAS cpxv* Z, int tid, const cpx (&twA)[16]) {
#ifndef FFT_HOST
    asm volatile("" : "+v"(tid));
#endif
    const int i = tid >> 6;
#pragma unroll 1
    for (int h = 0; h < 2; ++h) {
        const int o = (tid & 63) + 64 * h;
        cpx x[16];
#pragma unroll
        for (int j = 0; j < 16; ++j) x[j] = ldz(Z, DIM == 0 ? (i + 8 * j) * FFT_P + o : o * FFT_P + i + 8 * j);
        if (INV) {
#pragma unroll
            for (int j = 1; j < 16; ++j) x[j] = cmulc(x[j], twA[j]);
        }
        dft16<INV>(x);
        if (!INV) {
#pragma unroll
            for (int j = 1; j < 16; ++j) x[j] = cmul(x[j], twA[j]);
        }
#pragma unroll
        for (int j = 0; j < 16; ++j) stz(Z, DIM == 0 ? (i + 8 * j) * FFT_P + o : o * FFT_P + i + 8 * j, x[j]);
    }
}
template <bool INV, int DIM> FFT_HD void pass8(FFT_LAS cpxv* Z, int tid) {
#ifndef FFT_HOST
    asm volatile("" : "+v"(tid));
#endif
#pragma unroll 1
    for (int q = 0; q < 4; ++q) {
        const int item = tid + 512 * q, o = item & 127, jp = item >> 7;
        cpx x[8];
#pragma unroll
        for (int m = 0; m < 8; ++m) x[m] = ldz(Z, DIM == 0 ? (8 * jp + m) * FFT_P + o : o * FFT_P + 8 * jp + m);
        if (DIM == 0) {
            const cpx w1 = ldz(Z, FFT_TW1 + item), ws = ldz(Z, FFT_TWS + o);
            if (INV) { cpx w = w1;
#pragma unroll
                for (int m = 0; m < 8; ++m) { x[m] = cmulc(x[m], w); if (m < 7) w = cmul(w, ws); } }
            dft8<INV>(x);
            if (!INV) { cpx w = w1;
#pragma unroll
                for (int m = 0; m < 8; ++m) { x[m] = cmul(x[m], w); if (m < 7) w = cmul(w, ws); } }
        } else dft8<INV>(x);
#pragma unroll
        for (int m = 0; m < 8; ++m) stz(Z, DIM == 0 ? (8 * jp + m) * FFT_P + o : o * FFT_P + 8 * jp + m, x[m]);
    }
}
FFT_HD int pos_of(int k) { return kinv(k & 127) * FFT_P + kinv(k >> 7); }
constexpr int LDS_RED = (128 * FFT_P + 2048 + 128 + 128) * 8;
static_assert(LDS_RED + 256 <= LDS_MISC, "LDS map");
__device__ __forceinline__ void fft_tables(LAS cpxv* Z, int tid, const cpxv* tw) {
    for (int e = tid; e < 2048; e += 512) Z[FFT_TW1 + e] = tw[((e >> 7) * (e & 127)) & 16383];
    if (tid < 128) { Z[FFT_TWS + tid] = tw[(16 * tid) & 16383]; Z[FFT_TWA + tid] = tw[128 * tid]; }
    __syncthreads();
}
__device__ __forceinline__ void load_twA(LAS cpxv* Z, int tid, cpx (&twA)[16]) { const int i = tid >> 6;
#pragma unroll
    for (int j = 0; j < 16; ++j) twA[j] = ldz(Z, FFT_TWA + ((i * j) & 127)); }
struct BgNone { __device__ __forceinline__ void load() {} __device__ __forceinline__ void put() {} };
struct BgScan {
    const unsigned* dS; unsigned* Sin; const float* dec; int q, dh, r2, kk, d; float s0, s1; unsigned x[4]; f32x2 dc[4];
    __device__ __forceinline__ void init(const Ctx& X, int e) { dS = (const unsigned*)(X.ws + R_DST); Sin = (unsigned*)(X.ws + R_SINT); dec = (const float*)(X.ws + R_DEC);
        dh = e / (DV * DK / 2); r2 = e % (DV * DK / 2); kk = (2 * r2) & (DK - 1); d = dh / NH; q = 0; s0 = 0.f; s1 = 0.f; }
    __device__ __forceinline__ int chunk(int qq) const { const int c = qq < NCH ? qq : NCH - 1; return d == 0 ? c : NCH - 1 - c; }
    __device__ __forceinline__ void load() {
#pragma unroll
        for (int j = 0; j < 4; ++j) { const int n = chunk(q + j); x[j] = dS[((size_t)dh * NCH + n) * (DV * DK / 2) + r2]; dc[j] = *(const f32x2*)(dec + ((size_t)dh * NCH + n) * DK + kk); }
    }
    __device__ __forceinline__ void put() {
        if (q < NCH) {
#pragma unroll
            for (int j = 0; j < 4; ++j) { const int n = chunk(q + j); Sin[((size_t)dh * NCH + n) * (DV * DK / 2) + r2] = pk2(s0, s1);
                s0 = s0 * dc[j][0] + bf2f(x[j] & 0xffffu); s1 = s1 * dc[j][1] + bf2f(x[j] >> 16); }
            q += 4;
        }
    }
    __device__ __forceinline__ void finish() { while (q < NCH) { load(); put(); } }
};
template <class BG> __device__ __forceinline__ void fft_fwd(LAS cpxv* Z, int tid, const cpxv* tw, BG& bg) {
    cpx twA[16]; load_twA(Z, tid, twA);
    bg.load(); pass16<false, 0>(Z, tid, twA); lds_barrier(); bg.put();
    bg.load(); pass8<false, 0>(Z, tid); lds_barrier(); bg.put();
    bg.load(); pass16<false, 1>(Z, tid, twA); lds_barrier(); bg.put();
    bg.load(); pass8<false, 1>(Z, tid); lds_barrier(); bg.put();
}

template <class BG> __device__ __forceinline__ void fft_inv(LAS cpxv* Z, int tid, const cpxv* tw, BG& bg) {
    cpx twA[16]; load_twA(Z, tid, twA);
    bg.load(); pass8<true, 1>(Z, tid); lds_barrier(); bg.put();
    bg.load(); pass16<true, 1>(Z, tid, twA); lds_barrier(); bg.put();
    bg.load(); pass8<true, 0>(Z, tid); lds_barrier(); bg.put();
    bg.load(); pass16<true, 0>(Z, tid, twA); lds_barrier(); bg.put();
}
__device__ __forceinline__ void spectra_task(const Ctx& X, int l, int o, int p, const bf16* k4T) {
    LAS cpxv* Z = (LAS cpxv*)X.lds; const cpxv* tw = (const cpxv*)(X.ws + WS_TW);
    const int tid = X.tid, t0 = 128 * (tid & 63) + 16 * (tid >> 6), c0 = 2 * p;
    float fa[16], fb[16], ba[16], bb[16];
    const float MIND = -3.0701134573253944f, MAXD = -15.350567286626972f;
    const float da = fabsf(MIND + (MAXD - MIND) * ((float)c0 / 1023.0f)), db = fabsf(MIND + (MAXD - MIND) * ((float)(c0 + 1) / 1023.0f));
    const bf16* r_fa = k4T + (size_t)(o * 2048 + c0) * L + t0; const bf16* r_ba = k4T + (size_t)(o * 2048 + 1024 + c0) * L + t0;
    float sa = 0.f, sb = 0.f;
#pragma unroll
    for (int q = 0; q < 4; ++q) { const v2u u0 = *(const v2u*)(r_fa + 4 * q), u1 = *(const v2u*)(r_fa + L + 4 * q), u2 = *(const v2u*)(r_ba + 4 * q), u3 = *(const v2u*)(r_ba + L + 4 * q);
        const f32x4 v0 = (f32x4){bf2f(u0.x & 0xffffu), bf2f(u0.x >> 16), bf2f(u0.y & 0xffffu), bf2f(u0.y >> 16)}, v1 = (f32x4){bf2f(u1.x & 0xffffu), bf2f(u1.x >> 16), bf2f(u1.y & 0xffffu), bf2f(u1.y >> 16)};
        const f32x4 v2 = (f32x4){bf2f(u2.x & 0xffffu), bf2f(u2.x >> 16), bf2f(u2.y & 0xffffu), bf2f(u2.y >> 16)}, v3 = (f32x4){bf2f(u3.x & 0xffffu), bf2f(u3.x >> 16), bf2f(u3.y & 0xffffu), bf2f(u3.y >> 16)};
#pragma unroll
        for (int j = 0; j < 4; ++j) { const int i = 4 * q + j; const float tn = (float)(t0 + i) * (1.0f / 8191.0f); const float wa = fexp(-tn * da), wb = fexp(-tn * db);
            fa[i] = v0[j] * wa; fb[i] = v1[j] * wb; ba[i] = v2[j] * wa; bb[i] = v3[j] * wb;
            sa += fabsf(fa[i]); sb += fabsf(fb[i]); if (t0 + i > 0) { sa += fabsf(ba[i]); sb += fabsf(bb[i]); } } }
    LAS float* red = (LAS float*)(X.lds + LDS_RED);
    sa = wave_sum(sa); sb = wave_sum(sb);
    if (X.lane == 0) { red[X.wave] = sa; red[8 + X.wave] = sb; }
    lds_barrier();
    float Sa = 0.f, Sb = 0.f;
#pragma unroll
    for (int w = 0; w < 8; ++w) { Sa += red[w]; Sb += red[8 + w]; }
    const float ia = 1.0f / Sa, ib = 1.0f / Sb;
#pragma unroll
    for (int i = 0; i < 16; ++i) { const int t = t0 + i; Z[(t >> 7) * FFT_P + (t & 127)] = (cpxv){fa[i] * ia, fb[i] * ib};
        const int n = t > 0 ? 2 * L - t : L;
        Z[(n >> 7) * FFT_P + (n & 127)] = (cpxv){t > 0 ? ba[i] * ia : 0.f, t > 0 ? bb[i] * ib : 0.f}; }
    lds_barrier();
    { BgNone bgn; fft_fwd(Z, tid, tw, bgn); }
    v2u* PM = (v2u*)(X.ws + WS_PM + (size_t)l * PM_LAYER) + (size_t)(o * 512 + p) * PMJ;
    const float sc = 0.5f / (float)NFFT;
#pragma unroll 1
    for (int q = 0; q < 17; ++q) { const int j = tid + 512 * q; if (j > 8192) break;
        const cpxv a = Z[pos_of(j)], b = Z[pos_of((NFFT - j) & (NFFT - 1))];
        const float kax = (a.x + b.x) * 0.5f, kay = (a.y - b.y) * 0.5f, kbx = (a.y + b.y) * 0.5f, kby = -(a.x - b.x) * 0.5f;
        PM[j] = (v2u){pk2((kax + kbx) * sc, (kay + kby) * sc), pk2((kax - kbx) * sc, (kay - kby) * sc)}; }
    lds_barrier();
}
struct Raw16 { v4u a, b; unsigned prev, next; };
__device__ __forceinline__ Raw16 load_raw16(const bf16* u, int t0) { Raw16 r; r.a = *(const v4u*)(u + t0); r.b = *(const v4u*)(u + t0 + 8); r.prev = t0 > 0 ? u[t0 - 1] : 0u; r.next = t0 + 16 < L ? u[t0 + 16] : 0u; return r; }
__device__ __forceinline__ void conv_raw16(const Raw16& r, float w0, float w1, float w2, float b, float (&o)[16]) {
    float v[18];
    v[0] = bf2f(r.prev); v[17] = bf2f(r.next);
    v[1] = bf2f(r.a.x & 0xffffu); v[2] = bf2f(r.a.x >> 16); v[3] = bf2f(r.a.y & 0xffffu); v[4] = bf2f(r.a.y >> 16); v[5] = bf2f(r.a.z & 0xffffu); v[6] = bf2f(r.a.z >> 16); v[7] = bf2f(r.a.w & 0xffffu); v[8] = bf2f(r.a.w >> 16);
    v[9] = bf2f(r.b.x & 0xffffu); v[10] = bf2f(r.b.x >> 16); v[11] = bf2f(r.b.y & 0xffffu); v[12] = bf2f(r.b.y >> 16); v[13] = bf2f(r.b.z & 0xffffu); v[14] = bf2f(r.b.z >> 16); v[15] = bf2f(r.b.w & 0xffffu); v[16] = bf2f(r.b.w >> 16);
#pragma unroll
    for (int i = 0; i < 16; ++i) o[i] = w0 * v[i] + w1 * v[i + 1] + w2 * v[i + 2] + b;
}
__device__ __forceinline__ void load_conv16(const bf16* u, int t0, float w0, float w1, float w2, float b, float (&o)[16]) {
    const v4u x0 = *(const v4u*)(u + t0), x1 = *(const v4u*)(u + t0 + 8);
    float v[18];
    v[0] = t0 > 0 ? bf2f(u[t0 - 1]) : 0.f; v[17] = t0 + 16 < L ? bf2f(u[t0 + 16]) : 0.f;
    v[1] = bf2f(x0.x & 0xffffu); v[2] = bf2f(x0.x >> 16); v[3] = bf2f(x0.y & 0xffffu); v[4] = bf2f(x0.y >> 16); v[5] = bf2f(x0.z & 0xffffu); v[6] = bf2f(x0.z >> 16); v[7] = bf2f(x0.w & 0xffffu); v[8] = bf2f(x0.w >> 16);
    v[9] = bf2f(x1.x & 0xffffu); v[10] = bf2f(x1.x >> 16); v[11] = bf2f(x1.y & 0xffffu); v[12] = bf2f(x1.y >> 16); v[13] = bf2f(x1.z & 0xffffu); v[14] = bf2f(x1.z >> 16); v[15] = bf2f(x1.w & 0xffffu); v[16] = bf2f(x1.w >> 16);
#pragma unroll
    for (int i = 0; i < 16; ++i) o[i] = w0 * v[i] + w1 * v[i + 1] + w2 * v[i + 2] + b;
}
__device__ __forceinline__ int hy_jmap(int tid, int q) { return kmap(tid & 127) + 128 * (4 * q + (tid >> 7)); }
__device__ __forceinline__ void hy_pair(LAS cpxv* Z, int j, v2u pm) {
    const int p = pos_of(j), pp = pos_of((NFFT - j) & (NFFT - 1)); cpx P, M; P.x = bf2f(pm.x & 0xffffu); P.y = bf2f(pm.x >> 16); M.x = bf2f(pm.y & 0xffffu); M.y = bf2f(pm.y >> 16);
    const cpx zp = ldz(Z, p), zq = ldz(Z, pp);
    const cpx y1 = cadd(cmul(zp, P), cmul(cconj(zq), M)), y2 = cadd(cmulc(zq, P), cconj(cmul(zp, M)));
    stz(Z, p, y1); if (pp != p) stz(Z, pp, y2);
}
__device__ __forceinline__ void hy_pointwise(LAS cpxv* Z, const v2u* PM, const v2u (&pm)[16], int tid) {
    asm volatile("" : "+v"(tid));
#pragma unroll
    for (int q = 0; q < 16; ++q) { hy_pair(Z, hy_jmap(tid, q), pm[q]); if ((q & 3) == 3) __builtin_amdgcn_sched_barrier(0); }
    if (tid == 0) hy_pair(Z, 8192, PM[8192]);
    lds_barrier();
}
__device__ __forceinline__ void hy_fill(LAS cpxv* Z, int tid, const float (&za)[16], const float (&zb)[16]) {
    asm volatile("" : "+v"(tid));
    const int t0 = 128 * (tid & 63) + 16 * (tid >> 6);
#pragma unroll
    for (int i = 0; i < 16; ++i) { const int t = t0 + i; Z[(t >> 7) * FFT_P + (t & 127)] = (cpxv){za[i], zb[i]}; }
#pragma unroll
    for (int q = 0; q < 16; ++q) { const int e = tid + 512 * q; Z[(64 + (e >> 7)) * FFT_P + (e & 127)] = (cpxv){0.f, 0.f}; }
    lds_barrier();
}
template <class BG> __device__ __forceinline__ void hyena_task(const Ctx& X, int l, int p, BG& bg) {
    LAS cpxv* Z = (LAS cpxv*)X.lds; const cpxv* tw = (const cpxv*)(X.ws + WS_TW);
    const int tid = X.tid, t0 = 128 * (tid & 63) + 16 * (tid >> 6), c0 = 2 * p, c1 = c0 + 1;
    const bf16* uT = (const bf16*)(X.ws + R_UT); const float* cw = X.in(I_CONV_W) + (size_t)l * 3 * 3072; const float* cb = X.in(I_CONV_B) + (size_t)l * 3072; const float* skip = X.in(I_SKIP) + (size_t)l * 2 * 1024;
    float za[16], zb[16];
    load_conv16(uT + (size_t)c0 * L, t0, cw[c0], cw[3072 + c0], cw[2 * 3072 + c0], cb[c0], za);
    load_conv16(uT + (size_t)c1 * L, t0, cw[c1], cw[3072 + c1], cw[2 * 3072 + c1], cb[c1], zb);
#pragma unroll 1
    for (int o = 0; o < 2; ++o) {
        const v2u* PM = (const v2u*)(X.ws + WS_PM + (size_t)l * PM_LAYER) + (size_t)(o * 512 + p) * PMJ; v2u pm[16];
        const int ch0 = (o + 1) * 1024 + c0, ch1 = ch0 + 1;
        const Raw16 ra = load_raw16(uT + (size_t)ch0 * L, t0), rb = load_raw16(uT + (size_t)ch1 * L, t0);
        { int tq = tid; asm volatile("" : "+v"(tq));
#pragma unroll
          for (int q = 0; q < 16; ++q) pm[q] = PM[hy_jmap(tq, q)]; }
        hy_fill(Z, tid, za, zb);
#if defined(PROBE_FILL)
        for (int rr = 0; rr < PROBE_FILL; ++rr) hy_fill(Z, tid, za, zb);
#endif
#if defined(PROBE_FFT) && PROBE_FFT
        for (int rr = 0; rr < PROBE_FFT; ++rr) { BgNone bgn; fft_fwd(Z, tid, tw, bgn); fft_inv(Z, tid, tw, bgn);
            for (int e = tid; e < 128 * 128; e += 512) { const int ix = (e >> 7) * FFT_P + (e & 127); cpxv v = Z[ix]; v.x *= (1.0f / NFFT); v.y *= (1.0f / NFFT); Z[ix] = v; }
            __syncthreads(); }
#endif
        fft_fwd(Z, tid, tw, bg);
        hy_pointwise(Z, PM, pm, tid);
        fft_inv(Z, tid, tw, bg);
        float xa[16], xb_[16];
        conv_raw16(ra, cw[ch0], cw[3072 + ch0], cw[2 * 3072 + ch0], cb[ch0], xa);
        conv_raw16(rb, cw[ch1], cw[3072 + ch1], cw[2 * 3072 + ch1], cb[ch1], xb_);
        const float ska = skip[o * 1024 + c0], skb = skip[o * 1024 + c1];
        int t0r = t0; asm volatile("" : "+v"(t0r));
#pragma unroll
        for (int i = 0; i < 16; ++i) { const int t = t0r + i; const cpxv y = Z[(t >> 7) * FFT_P + (t & 127)];
            za[i] = xa[i] * (y.x + za[i] * ska); zb[i] = xb_[i] * (y.y + zb[i] * skb); }
        lds_barrier();
    }
    bf16* hyT = (bf16*)(X.ws + R_HYT);
    v4u w0, w1;
    w0.x = pk2(za[0], za[1]); w0.y = pk2(za[2], za[3]); w0.z = pk2(za[4], za[5]); w0.w = pk2(za[6], za[7]); w1.x = pk2(za[8], za[9]); w1.y = pk2(za[10], za[11]); w1.z = pk2(za[12], za[13]); w1.w = pk2(za[14], za[15]);
    *(v4u*)(hyT + (size_t)c0 * L + t0) = w0; *(v4u*)(hyT + (size_t)c0 * L + t0 + 8) = w1;
    w0.x = pk2(zb[0], zb[1]); w0.y = pk2(zb[2], zb[3]); w0.z = pk2(zb[4], zb[5]); w0.w = pk2(zb[6], zb[7]); w1.x = pk2(zb[8], zb[9]); w1.y = pk2(zb[10], zb[11]); w1.z = pk2(zb[12], zb[13]); w1.w = pk2(zb[14], zb[15]);
    *(v4u*)(hyT + (size_t)c1 * L + t0) = w0; *(v4u*)(hyT + (size_t)c1 * L + t0 + 8) = w1;
}
__device__ __forceinline__ f32x4 mma16_lds(const LAS bf16* A, int lda, const LAS bf16* Bt, int ldb, int K, int lane, f32x4 acc) {
    const LAS bf16* ap = A + (lane & 15) * lda + 8 * (lane >> 4); const LAS bf16* bp = Bt + (lane & 15) * ldb + 8 * (lane >> 4);
    for (int kb = 0; kb < K; kb += 32) { const bf16x8 a = *(const LAS bf16x8*)(ap + kb), b = *(const LAS bf16x8*)(bp + kb); acc = __builtin_amdgcn_mfma_f32_16x16x32_bf16(a, b, acc, 0, 0, 0); }
    return acc;
}
__device__ __forceinline__ void lr_phase(const Ctx& X, int l, const u64* sumsq) {
    const bf16* xb = (const bf16*)(X.ws + WS_XB); const bf16* W = (const bf16*)(X.ws + WS_W + l * W_LAYER + W_LR); float* lr = (float*)(X.ws + WS_LR);
    LAS float* red = (LAS float*)X.lds;
    const int lane = X.lane, w = X.wave;
    for (int u = X.bid; u < L / 32; u += X.G) {
        const int r0 = 32 * u; f32x4 acc[2][2] = {{{0.f, 0.f, 0.f, 0.f}, {0.f, 0.f, 0.f, 0.f}}, {{0.f, 0.f, 0.f, 0.f}, {0.f, 0.f, 0.f, 0.f}}};
#pragma unroll
        for (int ks = 0; ks < 8; ++ks) { const int k = 256 * w + 32 * ks + 8 * (lane >> 4); bf16x8 a[2], b[2];
#pragma unroll
            for (int i = 0; i < 2; ++i) { a[i] = *(const bf16x8*)(xb + (size_t)(r0 + 16 * i + (lane & 15)) * D + k); b[i] = *(const bf16x8*)(W + (size_t)(16 * i + (lane & 15)) * D + k); }
#pragma unroll
            for (int i = 0; i < 2; ++i)
#pragma unroll
                for (int j = 0; j < 2; ++j) acc[i][j] = __builtin_amdgcn_mfma_f32_16x16x32_bf16(a[i], b[j], acc[i][j], 0, 0, 0); }
#pragma unroll
        for (int i = 0; i < 2; ++i)
#pragma unroll
            for (int j = 0; j < 2; ++j) *(LAS f32x4*)(red + ((w * 4 + i * 2 + j) * 64 + lane) * 4) = acc[i][j];
        lds_barrier();
        if (X.tid < 256) { const int tile = X.tid >> 6, ln = X.tid & 63; f32x4 s = (f32x4){0.f, 0.f, 0.f, 0.f};
#pragma unroll
            for (int ww = 0; ww < 8; ++ww) s += *(LAS f32x4*)(red + ((ww * 4 + tile) * 64 + ln) * 4);
            const int i = tile >> 1, j = tile & 1, col = 16 * j + (ln & 15);
#pragma unroll
            for (int rg = 0; rg < 4; ++rg) { const int row = r0 + 16 * i + 4 * (ln >> 4) + rg; lr[(size_t)row * 32 + col] = s[rg] * rstd_of(sumsq, row); } }
        lds_barrier();
    }
}
constexpr int G1_QT = 0, G1_KT = 17408, G1_KOT = 0, G1_SC = 18432, G1_V = 34816, G1_VT = 68608, G1_QI = 105472, G1_KI = 122880, G1_LRS = 140288, G1_TOT = 148480;
static_assert(G1_TOT + 4096 <= LDS_MISC, "G1 LDS map");
template <int DIR> __device__ __forceinline__ void g1_dir(const Ctx& X, int h, int n, int kk, int rg, const float (&cum)[16], float off, float tot, const float (&qv)[16], const float (&kv)[16], f32x4 (&oacc)[2][4]) {
    LAS bf16* QI = (LAS bf16*)(X.lds + G1_QI); LAS bf16* KI = (LAS bf16*)(X.lds + G1_KI); LAS bf16* KOT = (LAS bf16*)(X.lds + G1_KOT); LAS bf16* VT = (LAS bf16*)(X.lds + G1_VT); LAS bf16* SC = (LAS bf16*)(X.lds + G1_SC);
    const int lane = X.lane, w = X.wave, t0 = 64 * n;
    unsigned ko[8];
#pragma unroll
    for (int i = 0; i < 16; ++i) { const int row = 16 * rg + i; const float b = off + cum[i];
        const float qi = qv[i] * 0.08838834764831845f * fexp(b), ki = kv[i] * fexp(-b), kov = kv[i] * fexp(tot - b);
        QI[row * 136 + kk] = (bf16)f2bf(qi); KI[row * 136 + kk] = (bf16)f2bf(ki);
        if (i & 1) ko[i >> 1] |= f2bf(kov) << 16; else ko[i >> 1] = f2bf(kov); }
    *(LAS v4u*)(KOT + kk * 72 + 16 * rg) = (v4u){ko[0], ko[1], ko[2], ko[3]}; *(LAS v4u*)(KOT + kk * 72 + 16 * rg + 8) = (v4u){ko[4], ko[5], ko[6], ko[7]};
    if (rg == 0) ((float*)(X.ws + R_DEC))[((size_t)(DIR * NH + h) * NCH + n) * DK + kk] = fexp(tot);
    lds_barrier();
    { bf16* qig = (bf16*)(X.ws + R_QI) + ((size_t)DIR * L + t0) * DKT + h * DK;
#pragma unroll
      for (int i = 0; i < 2; ++i) { const int id = X.tid + 512 * i, row = id >> 4, c16 = id & 15; *(v4u*)(qig + (size_t)row * DKT + 8 * c16) = *(const LAS v4u*)(QI + row * 136 + 8 * c16); } }
#pragma unroll
    for (int tt = 0; tt < 2; ++tt) { const int tile = 2 * w + tt, mj = tile >> 2, ni = tile & 3;
        f32x4 s = mma16_lds(KI + 16 * mj * 136, 136, QI + 16 * ni * 136, 136, 128, lane, (f32x4){0.f, 0.f, 0.f, 0.f});
        const int i = 16 * ni + (lane & 15), j0 = 16 * mj + 4 * (lane >> 4);
#pragma unroll
        for (int r = 0; r < 4; ++r) { const bool keep = DIR == 0 ? (j0 + r <= i) : (j0 + r > i); if (!keep) s[r] = 0.f; }
        *(LAS v2u*)(SC + i * 72 + j0) = (v2u){pk2(s[0], s[1]), pk2(s[2], s[3])}; }
    lds_barrier();
#pragma unroll
    for (int a = 0; a < 2; ++a)
#pragma unroll
        for (int b = 0; b < 4; ++b) oacc[a][b] = mma16_lds(VT + 16 * (2 * w + a) * 72, 72, SC + 16 * b * 72, 72, 64, lane, oacc[a][b]);
    bf16* dst = (bf16*)(X.ws + R_DST) + ((size_t)(DIR * NH + h) * NCH + n) * (DV * DK);
#pragma unroll 1
    for (int mk = 0; mk < 8; ++mk)
#pragma unroll
        for (int a = 0; a < 2; ++a) { const int nv = 2 * w + a;
            const f32x4 s = mma16_lds(KOT + 16 * mk * 72, 72, VT + 16 * nv * 72, 72, 64, lane, (f32x4){0.f, 0.f, 0.f, 0.f});
            *(v2u*)(dst + (size_t)(16 * nv + (lane & 15)) * DK + 16 * mk + 4 * (lane >> 4)) = (v2u){pk2(s[0], s[1]), pk2(s[2], s[3])}; }
    lds_barrier();
}
__device__ __forceinline__ void gla_g1(const Ctx& X, int l, int h, int n) {
    const int tid = X.tid, kk = tid & 127, rg = tid >> 7, t0 = 64 * n;
    const bf16* qkvr = (const bf16*)(X.ws + R_QKVR);
    LAS float* LRS = (LAS float*)(X.lds + G1_LRS); LAS float* TOT = (LAS float*)(X.lds + G1_TOT); LAS bf16* VT = (LAS bf16*)(X.lds + G1_VT);
    LAS bf16* QT = (LAS bf16*)(X.lds + G1_QT); LAS bf16* KT = (LAS bf16*)(X.lds + G1_KT); LAS bf16* VR = (LAS bf16*)(X.lds + G1_V);
    {
      v4u qc[2], kc[2], vc4[4];
#pragma unroll
      for (int i = 0; i < 2; ++i) { const int id = tid + 512 * i, row = id >> 4, c16 = id & 15; const bf16* rp = qkvr + (size_t)(t0 + row) * 3072 + h * DK + 8 * c16; qc[i] = *(const v4u*)rp; kc[i] = *(const v4u*)(rp + 512); }
#pragma unroll
      for (int i = 0; i < 4; ++i) { const int id = tid + 512 * i, row = id >> 5, c16 = id & 31; vc4[i] = *(const v4u*)(qkvr + (size_t)(t0 + row) * 3072 + 1024 + h * DV + 8 * c16); }
      const f32x4 lrv = *(const f32x4*)((const float*)(X.ws + WS_LR) + (size_t)t0 * 32 + 4 * tid);
#pragma unroll
      for (int i = 0; i < 2; ++i) { const int id = tid + 512 * i, row = id >> 4, c16 = id & 15; *(LAS v4u*)(QT + row * 136 + 8 * c16) = qc[i]; *(LAS v4u*)(KT + row * 136 + 8 * c16) = kc[i]; }
#pragma unroll
      for (int i = 0; i < 4; ++i) { const int id = tid + 512 * i, row = id >> 5, c16 = id & 31; *(LAS v4u*)(VR + row * 264 + 8 * c16) = vc4[i]; }
      *(LAS f32x4*)(LRS + 4 * tid) = lrv; }
    lds_barrier();
    {
      const int vc = tid & 255, tg = tid >> 8; unsigned pk[16];
#pragma unroll
      for (int i = 0; i < 32; ++i) { const unsigned x = VR[(32 * tg + i) * 264 + vc]; if (i & 1) pk[i >> 1] |= x << 16; else pk[i >> 1] = x; }
#pragma unroll
      for (int q = 0; q < 4; ++q) *(LAS v4u*)(VT + vc * 72 + 32 * tg + 8 * q) = (v4u){pk[4 * q], pk[4 * q + 1], pk[4 * q + 2], pk[4 * q + 3]}; }
    float qv[16], kv[16];
#pragma unroll
    for (int i = 0; i < 16; ++i) { qv[i] = bf2f(QT[(16 * rg + i) * 136 + kk]); kv[i] = bf2f(KT[(16 * rg + i) * 136 + kk]); }
    const float* w2 = X.in(I_GW2) + (size_t)l * 2 * LRK * DKT + h * DK + kk; const float* gb = X.in(I_GB) + (size_t)l * 2 * DKT + h * DK + kk;
    float wf[16], wb[16];
#pragma unroll
    for (int r = 0; r < 16; ++r) { wf[r] = w2[(size_t)r * DKT]; wb[r] = w2[(size_t)(LRK + r) * DKT]; }
    const float bf_ = gb[0], bb_ = gb[DKT];
    lds_barrier();
    float cf[16], cb[16];
#pragma unroll
    for (int i = 0; i < 16; ++i) { const LAS float* lrow = LRS + (16 * rg + i) * 32; float xf = bf_, xb2 = bb_;
#pragma unroll
        for (int r = 0; r < 16; ++r) { xf += lrow[r] * wf[r]; xb2 += lrow[16 + r] * wb[r]; }
        cf[i] = flogsigmoid(xf) * (1.0f / 16.0f); cb[i] = flogsigmoid(xb2) * (1.0f / 16.0f); }
#pragma unroll
    for (int i = 1; i < 16; ++i) cf[i] += cf[i - 1];
#pragma unroll
    for (int i = 14; i >= 0; --i) cb[i] += cb[i + 1];
    TOT[(0 * 4 + rg) * 128 + kk] = cf[15]; TOT[(1 * 4 + rg) * 128 + kk] = cb[0];
    lds_barrier();
    float offf = 0.f, totf = 0.f, offb = 0.f, totb = 0.f;
#pragma unroll
    for (int g = 0; g < 4; ++g) { const float a = TOT[(0 * 4 + g) * 128 + kk], b = TOT[(1 * 4 + g) * 128 + kk]; totf += a; totb += b; if (g < rg) offf += a; if (g > rg) offb += b; }
    f32x4 oacc[2][4];
#pragma unroll
    for (int a = 0; a < 2; ++a)
#pragma unroll
        for (int b = 0; b < 4; ++b) oacc[a][b] = (f32x4){0.f, 0.f, 0.f, 0.f};
    g1_dir<0>(X, h, n, kk, rg, cf, offf, totf, qv, kv, oacc);
    g1_dir<1>(X, h, n, kk, rg, cb, offb, totb, qv, kv, oacc);
    bf16* oi = (bf16*)(X.ws + R_OINTRA);
#pragma unroll
    for (int a = 0; a < 2; ++a)
#pragma unroll
        for (int b = 0; b < 4; ++b) *(v2u*)(oi + (size_t)(t0 + 16 * b + (X.lane & 15)) * DVT + h * DV + 16 * (2 * X.wave + a) + 4 * (X.lane >> 4)) = (v2u){pk2(oacc[a][b][0], oacc[a][b][1]), pk2(oacc[a][b][2], oacc[a][b][3])};
}
__device__ __forceinline__ void gla_g2(const Ctx& X, int first) {
    const unsigned* dS = (const unsigned*)(X.ws + R_DST); unsigned* Sin = (unsigned*)(X.ws + R_SINT); const float* dec = (const float*)(X.ws + R_DEC);
    for (int e = first; e < 2 * NH * DV * DK / 2; e += X.G * 512) {
        const int dh = e / (DV * DK / 2), r2 = e % (DV * DK / 2), kk = (2 * r2) & (DK - 1), d = dh / NH;
        float s0 = 0.f, s1 = 0.f;
#pragma unroll 8
        for (int q = 0; q < NCH; ++q) { const int n = d == 0 ? q : NCH - 1 - q; const size_t idx = ((size_t)dh * NCH + n) * (DV * DK / 2) + r2;
            const unsigned x = dS[idx]; const f32x2 dc = *(const f32x2*)(dec + ((size_t)dh * NCH + n) * DK + kk);
            Sin[idx] = pk2(s0, s1);
            s0 = s0 * dc[0] + bf2f(x & 0xffffu); s1 = s1 * dc[1] + bf2f(x >> 16); }
    }
}
constexpr int G3_QIL = 0, G3_RED = 36864;
__device__ __forceinline__ void gla_g3(const Ctx& X, int l, int h, int n) {
    const int lane = X.lane, w = X.wave, tid = X.tid, t0 = 64 * n;
    const bf16* SinT = (const bf16*)(X.ws + R_SINT); const bf16* qig = (const bf16*)(X.ws + R_QI); const bf16* oi = (const bf16*)(X.ws + R_OINTRA);
    const bf16* qkvr = (const bf16*)(X.ws + R_QKVR); bf16* gla = (bf16*)(X.ws + R_GLA); const float* ng = X.in(I_GNORM) + l * DV;
    LAS bf16* QIL = (LAS bf16*)(X.lds + G3_QIL);
    LAS float* RED = (LAS float*)(X.lds + G3_RED);
    v4u qc[4];
#pragma unroll
    for (int i = 0; i < 4; ++i) { const int id = tid + 512 * i, d = id >> 10, r = (id >> 4) & 63, c = id & 15; qc[i] = *(const v4u*)(qig + ((size_t)d * L + t0 + r) * DKT + h * DK + 8 * c); }
    bf16x8 av[2][2][4];
#pragma unroll
    for (int d = 0; d < 2; ++d) { const bf16* S = SinT + ((size_t)(d * NH + h) * NCH + n) * (DV * DK);
#pragma unroll
        for (int a = 0; a < 2; ++a)
#pragma unroll
            for (int ks = 0; ks < 4; ++ks) av[d][a][ks] = *(const bf16x8*)(S + (size_t)(16 * (2 * w + a) + (lane & 15)) * DK + 32 * ks + 8 * (lane >> 4)); }
    f32x4 ov[2][4]; v2u sr[2][4];
#pragma unroll
    for (int b = 0; b < 4; ++b)
#pragma unroll
        for (int a = 0; a < 2; ++a) { const size_t o = (size_t)(t0 + 16 * b + (lane & 15)) * DVT + h * DV + 16 * (2 * w + a) + 4 * (lane >> 4); { const v2u t_ = *(const v2u*)(oi + o); ov[a][b] = (f32x4){bf2f(t_.x & 0xffffu), bf2f(t_.x >> 16), bf2f(t_.y & 0xffffu), bf2f(t_.y >> 16)}; }
            sr[a][b] = *(const v2u*)(qkvr + (size_t)(t0 + 16 * b + (lane & 15)) * 3072 + 2048 + h * DV + 16 * (2 * w + a) + 4 * (lane >> 4)); }
#pragma unroll
    for (int i = 0; i < 4; ++i) { const int id = tid + 512 * i, d = id >> 10, r = (id >> 4) & 63, c = id & 15; *(LAS v4u*)(QIL + (d * 64 + r) * 136 + 8 * c) = qc[i]; }
    lds_barrier();
    f32x4 acc[2][4];
#pragma unroll
    for (int a = 0; a < 2; ++a)
#pragma unroll
        for (int b = 0; b < 4; ++b) acc[a][b] = (f32x4){0.f, 0.f, 0.f, 0.f};
#pragma unroll
    for (int d = 0; d < 2; ++d)
#pragma unroll
        for (int ks = 0; ks < 4; ++ks) { bf16x8 bv[4];
#pragma unroll
            for (int b = 0; b < 4; ++b) bv[b] = *(const LAS bf16x8*)(QIL + (d * 64 + 16 * b + (lane & 15)) * 136 + 32 * ks + 8 * (lane >> 4));
#pragma unroll
            for (int a = 0; a < 2; ++a)
#pragma unroll
                for (int b = 0; b < 4; ++b) acc[a][b] = __builtin_amdgcn_mfma_f32_16x16x32_bf16(av[d][a][ks], bv[b], acc[a][b], 0, 0, 0); }
    float ss[4];
#pragma unroll
    for (int b = 0; b < 4; ++b) { ss[b] = 0.f;
#pragma unroll
        for (int a = 0; a < 2; ++a) { acc[a][b] += ov[a][b];
            ss[b] += (acc[a][b][0] * acc[a][b][0] + acc[a][b][1] * acc[a][b][1]) + (acc[a][b][2] * acc[a][b][2] + acc[a][b][3] * acc[a][b][3]); }
        ss[b] += __shfl_xor(ss[b], 16); ss[b] += __shfl_xor(ss[b], 32);
        if (lane < 16) RED[w * 64 + 16 * b + lane] = ss[b]; }
    lds_barrier();
#pragma unroll
    for (int b = 0; b < 4; ++b) { const int tl = 16 * b + (lane & 15); float tot = 0.f;
#pragma unroll
        for (int ww = 0; ww < 8; ++ww) tot += RED[ww * 64 + tl];
        const float rs = __builtin_amdgcn_rsqf(tot * (1.0f / DV) + RMS_EPS);
#pragma unroll
        for (int a = 0; a < 2; ++a) { const int v0 = 16 * (2 * w + a) + 4 * (lane >> 4); const f32x4 g4 = *(const f32x4*)(ng + v0);
            const f32x4 o = acc[a][b] * rs * g4; const v2u s2 = sr[a][b];
            *(v2u*)(gla + (size_t)(t0 + tl) * DVT + h * DV + v0) = (v2u){pk2(o[0] * bf2f(s2.x & 0xffffu), o[1] * bf2f(s2.x >> 16)), pk2(o[2] * bf2f(s2.y & 0xffffu), o[3] * bf2f(s2.y >> 16))}; } }
    lds_barrier();
}
__device__ __forceinline__ void hy_transpose(const Ctx& X) {
    const bf16* hyT = (const bf16*)(X.ws + R_HYT); bf16* hy = (bf16*)(X.ws + R_HY);
    LAS bf16* scr = (LAS bf16*)(X.lds + 40960 + X.wave * 9216);
    const int lane = X.lane, r = lane >> 3, ch = lane & 7;
    for (int it = X.bid * 8 + X.wave; it < 16 * 128; it += X.G * 8) { const int c0 = 64 * (it >> 7), t0 = 64 * (it & 127);
        v4u v[8];
#pragma unroll
        for (int i = 0; i < 8; ++i) v[i] = *(const v4u*)(hyT + (size_t)(c0 + 8 * i + r) * L + t0 + 8 * ch);
#pragma unroll
        for (int i = 0; i < 8; ++i) *(LAS v4u*)(scr + (8 * i + r) * 72 + 8 * ch) = v[i];
        LDS_WAIT(); asm volatile("" ::: "memory");
#pragma unroll
        for (int i = 0; i < 8; ++i) { const int t = 8 * i + r; const LAS bf16* sp = scr + (8 * ch) * 72 + t;
            v4u o; o.x = (unsigned)sp[0] | ((unsigned)sp[72] << 16); o.y = (unsigned)sp[2 * 72] | ((unsigned)sp[3 * 72] << 16); o.z = (unsigned)sp[4 * 72] | ((unsigned)sp[5 * 72] << 16); o.w = (unsigned)sp[6 * 72] | ((unsigned)sp[7 * 72] << 16);
            *(v4u*)(hy + (size_t)(t0 + t) * HW + c0 + 8 * ch) = o; }
        LDS_WAIT(); asm volatile("" ::: "memory"); }
}
constexpr size_t WS_ROWSCALE = WS_TW + 256 * 1024, WS_ROWGATE = WS_TW + 512 * 1024;
__device__ __forceinline__ void router_phase(const Ctx& X, const u64* sumsq) {
    LAS float* WR = (LAS float*)X.lds;
    { const float* rw = X.in(I_ROUTER); const float* nf = X.in(I_NORM_FFN) + D;
      for (int i = X.tid; i < NE * D; i += 512) { const int e = i / D, k = i % D; WR[i] = rw[(size_t)k * NE + e] * nf[k]; } }
    __syncthreads();
    const float* xres = (const float*)(X.ws + WS_XRES); int* tok = (int*)(X.ctl + CW_TOK); unsigned* cnt = X.ctl + CW_CNT;
    for (int t = X.bid * 8 + X.wave; t < L; t += X.G * 8) {
        const f32x4* xr = (const f32x4*)(xres + (size_t)t * D) + X.lane; float lg[NE];
#pragma unroll
        for (int e = 0; e < NE; ++e) lg[e] = 0.f;
#pragma unroll 1
        for (int j = 0; j < 8; ++j) { const f32x4 v = xr[64 * j];
#pragma unroll
            for (int e = 0; e < NE; ++e) { const f32x4 wv = *(const LAS f32x4*)(WR + e * D + 4 * X.lane + 256 * j); lg[e] += (v[0] * wv[0] + v[1] * wv[1]) + (v[2] * wv[2] + v[3] * wv[3]); } }
        const float rs = rstd_of(sumsq, t);
#pragma unroll
        for (int e = 0; e < NE; ++e) lg[e] = wave_sum(lg[e]) * rs;
        int i1 = 0; float l1 = lg[0];
#pragma unroll
        for (int e = 1; e < NE; ++e) if (lg[e] > l1) { l1 = lg[e]; i1 = e; }
        int i2 = -1; float l2 = -3.0e38f;
#pragma unroll
        for (int e = 0; e < NE; ++e) if (e != i1 && lg[e] > l2) { l2 = lg[e]; i2 = e; }
        const float g1 = __builtin_amdgcn_rcpf(1.0f + fexp(l2 - l1)), g2 = 1.0f - g1;
        if (X.lane == 0) { const unsigned s1 = atomicAdd(cnt + i1, 1u), s2 = atomicAdd(cnt + i2, 1u);
            tok[t * 8 + 0] = i1; tok[t * 8 + 1] = (int)s1; tok[t * 8 + 2] = (int)__builtin_bit_cast(unsigned, g1); tok[t * 8 + 3] = i2; tok[t * 8 + 4] = (int)s2; tok[t * 8 + 5] = (int)__builtin_bit_cast(unsigned, g2); }
    }
}
__device__ __forceinline__ void moe_tables(const Ctx& X) {
    if (X.tid == 0) { unsigned tb = 0; for (int e = 0; e < NE; ++e) { const unsigned c = __hip_atomic_load(X.ctl + CW_CNT + e, RLX_AGENT), nt = (c + 255u) >> 8; X.misc[16 + e] = nt; X.misc[24 + e] = tb; tb += nt; }
        const unsigned U = 8u * tb, G = (unsigned)X.G; unsigned nnorm = (U / G) * G, urem = U - nnorm, S = 1u;
        if (urem > 0u && urem <= G / 4u) S = 4u; else if (urem > 0u && urem <= G / 2u) S = 2u;
        if (S == 1u) { nnorm = U; urem = 0u; }
        X.misc[32] = nnorm; X.misc[33] = S; X.misc[34] = urem; }
    __syncthreads();
}
__device__ __forceinline__ void gather_phase(const Ctx& X, const u64* sumsq) {
    moe_tables(X);
    const float* xres = (const float*)(X.ws + WS_XRES); unsigned char* xg = (unsigned char*)(X.ws + R_XG); int* tok = (int*)(X.ctl + CW_TOK);
    float* rowscale = (float*)(X.ws + WS_ROWSCALE); float* rowgate = (float*)(X.ws + WS_ROWGATE);
    f32x4 g[8];
#pragma unroll
    for (int j = 0; j < 8; ++j) g[j] = *((const f32x4*)(X.in(I_NORM_FFN) + D) + X.lane + 64 * j);
    for (int t = X.bid * 8 + X.wave; t < L; t += X.G * 8) {
        const f32x4* src = (const f32x4*)(xres + (size_t)t * D) + X.lane; unsigned v[8];
        const float rs = rstd_of(sumsq, t) * F8_ASCALE;
#pragma unroll
        for (int j = 0; j < 8; ++j) { f32x4 a = src[64 * j] * g[j] * rs;
#pragma unroll
            for (int q = 0; q < 4; ++q) a[q] = fminf(fmaxf(a[q], -448.0f), 448.0f);
            int w = 0; w = __builtin_amdgcn_cvt_pk_fp8_f32(a[0], a[1], w, false); w = __builtin_amdgcn_cvt_pk_fp8_f32(a[2], a[3], w, true); v[j] = (unsigned)w; }
#pragma unroll
        for (int s = 0; s < 2; ++s) { const int e = tok[t * 8 + 3 * s], slot = tok[t * 8 + 3 * s + 1]; const int row = 256 * (int)X.misc[24 + e] + slot;
            unsigned* dst = (unsigned*)(xg + (size_t)row * D) + X.lane;
#pragma unroll
            for (int j = 0; j < 8; ++j) dst[64 * j] = v[j];
            if (X.lane == 0) { rowscale[row] = 1.0f / (F8_WSCALE * F8_ASCALE); rowgate[row] = __builtin_bit_cast(float, (unsigned)tok[t * 8 + 3 * s + 2]) * (1.0f / (F8_WSCALE * F8_ACTSCALE));        tok[t * 8 + 6 + s] = row; } }
    }
}
__device__ __forceinline__ void add_moe_row(const Ctx& X, f32x4 (&x)[8], int r, int e) {
    const bf16* ys = (const bf16*)(X.ws + R_YS); const float* slab = (const float*)(X.ws + R_SLAB);
    const int S = (int)X.misc[33], nnorm = (int)X.misc[32], nt = (int)X.misc[16 + e], tb = (int)X.misc[24 + e], rt = (r >> 8) - tb;
    const v2u* y = (const v2u*)(ys + (size_t)r * D) + X.lane;
#pragma unroll
    for (int j = 0; j < 8; ++j) { const int Lw = 8 * tb + j * nt + rt;
        if (S > 1 && Lw >= nnorm) { const float* sp = slab + (size_t)((Lw - nnorm) * S) * 65536 + (size_t)(r & 255) * 256 + 4 * X.lane;
            for (int q = 0; q < S; ++q) x[j] += *(const f32x4*)(sp + (size_t)q * 65536); }
        else { const v2u a = y[64 * j]; x[j][0] += bf2f(a.x & 0xffffu); x[j][1] += bf2f(a.x >> 16); x[j][2] += bf2f(a.y & 0xffffu); x[j][3] += bf2f(a.y >> 16); } }
}
__device__ __forceinline__ void final_phase(const Ctx& X) {
    moe_tables(X);
    const float* xres = (const float*)(X.ws + WS_XRES); const int* tok = (const int*)(X.ctl + CW_TOK); const float* gf = X.in(I_NORM_FINAL);
    f32x4 g[8];
#pragma unroll
    for (int j = 0; j < 8; ++j) g[j] = *((const f32x4*)gf + X.lane + 64 * j);
    for (int t = X.bid * 8 + X.wave; t < L; t += X.G * 8) {
        const int e0 = tok[t * 8 + 0], e1 = tok[t * 8 + 3], r0 = tok[t * 8 + 6], r1 = tok[t * 8 + 7];
        const f32x4* xr = (const f32x4*)(xres + (size_t)t * D) + X.lane; f32x4 v[8];
#pragma unroll
        for (int j = 0; j < 8; ++j) v[j] = xr[64 * j];
        add_moe_row(X, v, r0, e0); add_moe_row(X, v, r1, e1);
        float s = 0.f;
#pragma unroll
        for (int j = 0; j < 8; ++j) s += (v[j][0] * v[j][0] + v[j][1] * v[j][1]) + (v[j][2] * v[j][2] + v[j][3] * v[j][3]);
        const float rs = __builtin_amdgcn_rsqf(wave_sum(s) * (1.0f / D) + RMS_EPS);
        f32x4* o = (f32x4*)(X.out + (size_t)t * D) + X.lane;
#pragma unroll
        for (int j = 0; j < 8; ++j) o[64 * j] = v[j] * rs * g[j];
    }
}
constexpr int N_PHASES = 22;
struct Args { const float* in[N_IN]; float* out; unsigned char* ws; int ph_lo, ph_hi; };
static_assert(sizeof(Args) == (N_IN + 2) * 8 + 8, "Args has no padding");
__global__ void __launch_bounds__(512, 2) fwd_kernel(Args args) {
    extern __shared__ __attribute__((aligned(16))) unsigned char lds_raw[];
    Ctx X;
    X.out = args.out; X.ws = args.ws; X.ctl = (unsigned*)(args.ws + WS_CTL); X.lds = (LAS unsigned char*)lds_raw; X.misc = (volatile LAS unsigned*)(X.lds + LDS_MISC);
    X.tid = threadIdx.x; X.lane = X.tid & 63; X.wave = __builtin_amdgcn_readfirstlane(X.tid >> 6); X.G = gridDim.x; X.bid = blockIdx.x;
    if (X.tid < 64) X.misc[X.tid] = 0u;
    if (X.tid == 0) {
#pragma unroll
        for (int i = 0; i < N_IN; ++i) { const unsigned long long v = (unsigned long long)args.in[i]; X.misc[64 + 2 * i] = (unsigned)v; X.misc[65 + 2 * i] = (unsigned)(v >> 32); } }
    __syncthreads();
    const int lo = args.ph_lo, hi = args.ph_hi;
    XcdBarrier bar; bar.bar = X.ctl + CW_BAR; bar.x = 0; bar.st = nullptr;
    if (hi - lo > 1) bar = xcd_barrier_post(X.ctl + CW_BAR, X.misc + 8);
#ifndef EN_MASK
#define EN_MASK 0xFFFF
#endif
#define EN(b) (((EN_MASK) >> (b)) & 1)
#define IN(k) (lo <= (k) && (k) < hi)
#ifndef DUP_MASK
#define DUP_MASK 0
#endif
#define DUPX(b) (1 + (((DUP_MASK) >> (b)) & 1))
#define REP(b) for (int rep_ = 0; rep_ < 1 + (((DUP_MASK) >> (b)) & 1); ++rep_)
#define SEAM(k) do { if (IN(k) && IN((k) + 1)) xcd_barrier(bar); } while (0)
#define PHX(Y) Ctx Y = X; { int t_ = threadIdx.x; asm volatile("" : "+v"(t_)); Y.tid = t_; Y.lane = t_ & 63; }
    unsigned char* ws = X.ws; u64* sumsq = (u64*)(X.ctl + CW_SUMSQ);
    LAS unsigned char* lds = X.lds;

    if (EN(0) && IN(0)) { PHX(Y) p0_misc<0>(Y); __syncthreads(); }
    SEAM(0);
    if (EN(1) && IN(1)) {
#pragma unroll 1
        for (int lf = 0; lf < 2; ++lf) { SchedGrid S{X.G, X.bid, 16, 32, (const char*)(ws + WS_W4T + (size_t)lf * 4096 * 256 * 2), (const char*)(ws + WS_H3B + (size_t)lf * L * 256 * 2), (size_t)256 * 256 * 2};
          EpiBf16Plain E{(bf16*)(ws + (lf ? R_K4T1 : R_K4T)), L}; int kf = 256; asm volatile("" : "+s"(kf));
          pg8::gemm_phase(lds, kf, S, E); __syncthreads(); }
        { PHX(Y) p0_misc<1>(Y); __syncthreads(); }
    }
    if (IN(1)) xcd_barrier(bar);
    if (EN(1) && IN(1)) {
        const bool sfirst = ((X.bid >> 3) & 1) != 0;
#pragma unroll 1
        for (int st = 0; st < 2; ++st) {
            if ((st == 0) == sfirst) {
                { PHX(Y) fft_tables((LAS cpxv*)Y.lds, Y.tid, (const cpxv*)(ws + WS_TW)); }
                { const int rem = (32 * 44) % X.G, early = rem != 0 ? 2 * (X.G - rem) : 0;
                  PHX(Y) for (int i0 = X.bid; i0 < 2048 - early; i0 += X.G) { const int it = i0 < 1024 ? i0 : i0 + early; spectra_task(Y, it >> 10, (it >> 9) & 1, it & 511, (const bf16*)(ws + ((it >> 10) ? R_K4T1 : R_K4T))); } }
                __syncthreads();
            } else { PHX(Y) p0_weights(Y); __syncthreads(); }
        }
    }
    SEAM(1);
#pragma unroll 1
    for (int l = 0; l < 2; ++l) {
        const int P = 1 + 9 * l;
        const size_t WL = WS_W + (size_t)l * W_LAYER;
        const u64* ss_mix = sumsq + (l == 0 ? 0 : 2 * L); u64* ss_ffn = sumsq + (l == 0 ? L : 3 * L);
        if (EN(2) && IN(P + 1)) {
            { PHX(Y) lr_phase(Y, l, ss_mix); }
            REP(4) { SchedWin S{X.G, X.bid, (const char*)(ws + WL + W_HY), (const char*)(ws + WL + W_REST), (const char*)(ws + WS_XB)};
              EpiWin E{(bf16*)(ws + R_UT), (bf16*)(ws + R_QKVR), (bf16*)(ws + R_SG), ss_mix}; pg8::gemm_phase(lds, D, S, E); }
        }
        SEAM(P + 1);
        if (EN(3) && IN(P + 2)) { PHX(Y) for (int it = X.bid; it < 512 * DUPX(7); it += X.G) gla_g1(Y, l, (it >> 7) & 3, it & 127); }
        SEAM(P + 2);
        if (EN(4) && IN(P + 3)) {
            { PHX(Y) fft_tables((LAS cpxv*)Y.lds, Y.tid, (const cpxv*)(ws + WS_TW)); }
            { PHX(Y) constexpr int NEL = 2 * NH * DV * DK / 2; BgScan bg; bg.init(Y, (X.bid * 512 + Y.tid) % NEL);
              for (int it = X.bid; it < 512 * DUPX(6); it += X.G) hyena_task(Y, l, it & 511, bg);
              bg.finish();
              gla_g2(Y, X.bid * 512 + Y.tid + X.G * 512); }
        }
        SEAM(P + 3);
        if (EN(5) && IN(P + 4)) { { PHX(Y) for (int it = X.bid; it < 512 * DUPX(9); it += X.G) gla_g3(Y, l, (it >> 7) & 3, it & 127); } REP(10) { PHX(Y) hy_transpose(Y); } }
        SEAM(P + 4);
        if (EN(6) && IN(P + 5)) REP(11) { SchedBranch S{X.G, X.bid, (const char*)(ws + R_HY), (const char*)(ws + R_GLA), (const char*)(ws + WL + W_A), (const char*)(ws + WL + W_B)};
            EpiBranch E{(const bf16*)(ws + R_SG), (bf16*)(ws + R_MIXED)}; pg8::gemm_phase(lds, 1024, S, E); }
        SEAM(P + 5);
        if (EN(7) && IN(P + 6)) { SchedGrid S{X.G, X.bid, 32, 8, (const char*)(ws + R_MIXED), (const char*)(ws + WL + W_O), (size_t)256 * D * 2};
            if (l == 0) { EpiResid<1> E{X.in(I_X), (float*)(ws + WS_XRES), (bf16*)(ws + WS_XB), ss_ffn}; pg8::gemm_phase(lds, D, S, E); }
            else { EpiResid<2> E{(const float*)(ws + WS_XRES), (float*)(ws + WS_XRES), nullptr, ss_ffn}; pg8::gemm_phase(lds, D, S, E); } }
        SEAM(P + 6);
        if (l == 0) {
            if (EN(8) && IN(8)) REP(12) { SchedGrid S{X.G, X.bid, 32, 44, (const char*)(ws + WS_XB), (const char*)(ws + WS_WFF + W_GU), (size_t)256 * D};
                EpiSwiglu E{(bf16*)(ws + R_ACT), ss_ffn, nullptr, 1.0f / (F8_WSCALE * F8_ASCALE)}; pg8::gemm_phase<EpiSwiglu, SchedGrid, true>(lds, D / 2, S, E); }
            if (EN(8) && IN(8)) { const int rem = (32 * 44) % X.G;
                if (rem != 0 && X.bid >= rem) { __syncthreads(); { PHX(Y) fft_tables((LAS cpxv*)Y.lds, Y.tid, (const cpxv*)(ws + WS_TW)); }
                    PHX(Y) for (int k = 0; k < 2; ++k) { const int it = (X.bid - rem) + (X.G - rem) * k; if (it < 1024) spectra_task(Y, 1, it >> 9, it & 511, (const bf16*)(ws + R_K4T1)); } } }
            SEAM(8);
            if (EN(9) && IN(9)) { SchedGrid S{X.G, X.bid, 32, 8, (const char*)(ws + R_ACT), (const char*)(ws + WS_WFF + W_DT), (size_t)256 * FF * 2};
                EpiResid<0> E{(const float*)(ws + WS_XRES), (float*)(ws + WS_XRES), (bf16*)(ws + WS_XB), sumsq + 2 * L}; pg8::gemm_phase(lds, FF, S, E); }
            SEAM(9);
        }
    }
    if (EN(10) && IN(17)) { PHX(Y) router_phase(Y, sumsq + 3 * L); }
    SEAM(17);
    if (EN(11) && IN(18)) { PHX(Y) gather_phase(Y, sumsq + 3 * L); }
    SEAM(18);
    if (EN(12) && IN(19)) REP(13) { moe_tables(X);
        const int vcu = (X.G % 8 == 0) ? (X.bid % 8) * (X.G / 8) + X.bid / 8 : X.bid;
        SchedMoe S{X.G, vcu, 44, 1 << 30, (const char*)(ws + R_XG), (const char*)(ws + WS_WFF + W_FFN + W_GU), (size_t)256 * D, W_FFN, X.misc};
        EpiSwigluT<true> E{(bf16*)(ws + R_ACTG), nullptr, (const float*)(ws + WS_ROWSCALE), 1.0f}; pg8::gemm_phase<EpiSwigluT<true>, SchedMoe, true>(lds, D / 2, S, E); }
    SEAM(19);
    if (EN(13) && IN(20)) REP(15) { moe_tables(X);
        const int vcu = (X.G % 8 == 0) ? (X.bid % 8) * (X.G / 8) + X.bid / 8 : X.bid;
        { SchedMoe S{X.G, vcu, 8, (int)X.misc[32], (const char*)(ws + R_ACTG), (const char*)(ws + WS_WFF + W_FFN + W_DT), (size_t)256 * FF, W_FFN, X.misc};
          EpiMoeDown E{(bf16*)(ws + R_YS), (const float*)(ws + WS_ROWGATE)}; pg8::gemm_phase<EpiMoeDown, SchedMoe, true>(lds, FF / 2, S, E); }
        const int Ssp = (int)X.misc[33];
        if (Ssp > 1) { SchedMoeSplit S{X.bid, (const char*)(ws + R_ACTG), (const char*)(ws + WS_WFF + W_FFN + W_DT), (size_t)256 * FF, W_FFN, X.misc};
          EpiMoeDownSplit E{(float*)(ws + R_SLAB), (const float*)(ws + WS_ROWGATE)}; pg8::gemm_phase<EpiMoeDownSplit, SchedMoeSplit, true>(lds, FF / 2, S, E, moe_split_tiles(Ssp, X.bid % Ssp)); } }
    SEAM(20);
    if (EN(14) && IN(21)) REP(14) { PHX(Y) final_phase(Y); }
#undef IN
#undef SEAM
}

extern "C" void kernel_launch(void* const* d_in, const int* in_sizes, int n_in, void* d_out, int out_size, void* d_ws, size_t ws_size, hipStream_t stream) {
    static int grid = 0;
    if (grid == 0) {
        if (n_in != N_IN || out_size != L * D || ws_size < WS_END) { fprintf(stderr, "kernel_launch: unexpected shapes (n_in %d, out %d, ws %zu < %zu)\n", n_in, out_size, ws_size, (size_t)WS_END); grid = -1; return; }
        int dev = 0, cus = 0, per_cu = 0;
        if (hipGetDevice(&dev) != hipSuccess || hipDeviceGetAttribute(&cus, hipDeviceAttributeMultiprocessorCount, dev) != hipSuccess) { grid = -1; return; }
        if (hipFuncSetAttribute((const void*)fwd_kernel, hipFuncAttributeMaxDynamicSharedMemorySize, LDS_BYTES) != hipSuccess) { fprintf(stderr, "kernel_launch: hipFuncSetAttribute failed\n"); grid = -1; return; }
        if (hipOccupancyMaxActiveBlocksPerMultiprocessor(&per_cu, (const void*)fwd_kernel, 512, LDS_BYTES) != hipSuccess || per_cu < 1) { fprintf(stderr, "kernel_launch: occupancy query says %d\n", per_cu); }
        (void)hipGetLastError();
        grid = cus;
    }
    if (grid < 0) return;
    if (hipMemsetAsync((char*)d_ws + WS_CTL, 0, CTL_ZERO_BYTES, stream) != hipSuccess) return;
    Args a{};
    for (int i = 0; i < N_IN; ++i) a.in[i] = (const float*)d_in[i];
    a.out = (float*)d_out; a.ws = (unsigned char*)d_ws;
#if MK_ONE_LAUNCH
    a.ph_lo = 0; a.ph_hi = N_PHASES;
    hipLaunchKernelGGL(fwd_kernel, dim3(grid), dim3(512), LDS_BYTES, stream, a);
#else
    for (int p = 0; p < N_PHASES; ++p) { a.ph_lo = p; a.ph_hi = p + 1; hipLaunchKernelGGL(fwd_kernel, dim3(grid), dim3(512), LDS_BYTES, stream, a); }
#endif
}
```

```cpp
#include <hip/hip_runtime.h>
#include <cstdio>
#include <cstdint>

#ifndef MK_ONE_LAUNCH
#define MK_ONE_LAUNCH 1
#endif

#define GAS __attribute__((address_space(1)))
#define LAS __attribute__((address_space(3)))
typedef unsigned short bf16;
typedef unsigned v4u __attribute__((ext_vector_type(4)));
typedef unsigned v2u __attribute__((ext_vector_type(2)));
typedef float f32x4 __attribute__((ext_vector_type(4)));
typedef float f32x2 __attribute__((ext_vector_type(2)));
typedef unsigned long long u64;
constexpr float SS_FIX = 16777216.0f, SS_UNFIX = 1.0f / 16777216.0f / 2048.0f;
typedef short bf16x8 __attribute__((ext_vector_type(8)));
#define RLX_AGENT __ATOMIC_RELAXED, __HIP_MEMORY_SCOPE_AGENT
#define LDS_WAIT() asm volatile("s_waitcnt lgkmcnt(0)" ::: "memory")
#define VM_WAIT() asm volatile("s_waitcnt vmcnt(0)" ::: "memory")

constexpr int L = 8192, D = 2048, HW = 1024, PIN = 10272, FF = 5632, NE = 8;
constexpr int NH = 4, DK = 128, DV = 256, LRK = 16, CH = 64, NCH = 128, DKT = 512, DVT = 1024;
constexpr int C_HY = 0, C_Q = 3072, C_K = 3584, C_V = 4096, C_R = 5120, C_LR = 6144, C_GA = 6176, C_GB = 8224;
constexpr float RMS_EPS = 1e-6f;
constexpr int NFFT = 16384;
constexpr int PMJ = 8208;
constexpr int MOE_ROWS = 18432;
enum { I_X = 0, I_NORM_MIX, I_W_IN, I_CONV_W, I_CONV_B, I_FW1, I_FB1, I_FF1, I_FW2, I_FB2, I_FF2, I_FW3, I_FB3, I_FF3, I_FW4, I_SKIP, I_WA, I_GW2, I_GB, I_GNORM, I_WB, I_WOUT,
       I_NORM_FFN, I_DWG, I_DWU, I_DWD, I_ROUTER, I_MWG, I_MWU, I_MWD, I_NORM_FINAL, N_IN };

constexpr size_t MiB = 1u << 20;
constexpr size_t WS_CTL = 0, CTL_ZERO_BYTES = 1 * MiB;
constexpr size_t WS_TW = 1 * MiB;
constexpr size_t WS_H3B = 2 * MiB;
constexpr size_t WS_W4T = 10 * MiB;
constexpr size_t WS_LR = 14 * MiB;
constexpr size_t WS_XRES = 16 * MiB;
constexpr size_t WS_XB = 80 * MiB;
constexpr size_t WS_W = 112 * MiB;
constexpr size_t W_HY = 0, W_REST = 12 * MiB, W_LR = 40 * MiB, W_A = 41 * MiB, W_B = 45 * MiB, W_O = 49 * MiB, W_LAYER = 57 * MiB;
constexpr size_t WS_WFF = WS_W + 2 * W_LAYER;
constexpr size_t W_GU = 0, W_DT = 44 * MiB, W_FFN = 66 * MiB;
constexpr size_t WS_PM = WS_WFF + 9 * W_FFN;
constexpr size_t PM_LAYER = (size_t)2 * 512 * PMJ * 8;
constexpr size_t WS_R = WS_PM + 130 * MiB;
constexpr size_t R_UT = WS_R, R_QKVR = WS_R + 48 * MiB, R_SG = WS_R + 96 * MiB, R_HYT = WS_R + 160 * MiB, R_HY = WS_R + 176 * MiB, R_GLA = WS_R + 192 * MiB,
                 R_MIXED = WS_R + 208 * MiB, R_QI = WS_R + 240 * MiB, R_OINTRA = WS_R + 256 * MiB, R_DST = WS_R + 288 * MiB, R_SINT = WS_R + 352 * MiB, R_DEC = WS_R + 416 * MiB,
                 R_K4T = WS_R + 288 * MiB  ;
constexpr size_t R_ACT = WS_R;
constexpr size_t R_XG = WS_R, R_ACTG = WS_R + 72 * MiB, R_YS = WS_R + 270 * MiB;
constexpr size_t R_SLAB = WS_R + 344 * MiB;
constexpr size_t R_K4T1 = WS_R + 418 * MiB;
constexpr size_t WS_END = R_K4T1 + 64 * MiB;
static_assert(R_YS + 72 * MiB <= WS_END && R_DEC + 1 * MiB <= WS_END, "ws map");
constexpr int CW_TMO = 0;
constexpr int CW_BAR = 4096;
constexpr int CW_CNT = 8192;
constexpr int CW_SUMSQ = 16384;
constexpr int CW_TOK = 131072;
static_assert((CW_TOK + 8192 * 8) * 4 <= (int)CTL_ZERO_BYTES, "ctl");
constexpr int LDS_BYTES = 155648;
constexpr int LDS_MISC = 151 * 1024;

constexpr float F8_ACTSCALE = 8.0f;
constexpr float F8_WSCALE = 64.0f, F8_ASCALE = 16.0f;
__device__ __forceinline__ unsigned f8pack4(float a0, float a1, float a2, float a3) {
    a0 = fminf(fmaxf(a0, -448.0f), 448.0f); a1 = fminf(fmaxf(a1, -448.0f), 448.0f); a2 = fminf(fmaxf(a2, -448.0f), 448.0f); a3 = fminf(fmaxf(a3, -448.0f), 448.0f);
    int w = 0; w = __builtin_amdgcn_cvt_pk_fp8_f32(a0, a1, w, false); w = __builtin_amdgcn_cvt_pk_fp8_f32(a2, a3, w, true); return (unsigned)w; }
__device__ __forceinline__ float bf2f(unsigned h) { return __builtin_bit_cast(float, h << 16); }
__device__ __forceinline__ unsigned f2bf(float f) { unsigned u = __builtin_bit_cast(unsigned, f); return (u + 0x7fffu + ((u >> 16) & 1u)) >> 16; }
__device__ __forceinline__ unsigned pk2(float lo, float hi) { return f2bf(lo) | (f2bf(hi) << 16); }
__device__ __forceinline__ float fexp(float x) { return __builtin_amdgcn_exp2f(x * 1.44269504088896341f); }
__device__ __forceinline__ float fsigmoid(float x) { return __builtin_amdgcn_rcpf(1.0f + fexp(-x)); }
__device__ __forceinline__ float fsilu(float x) { return x * fsigmoid(x); }
__device__ __forceinline__ float flogsigmoid(float x) { return fminf(x, 0.f) - 0.69314718056f * __builtin_amdgcn_logf(1.0f + fexp(-fabsf(x))); }
__device__ __forceinline__ float fsin_rev(float r) { return __builtin_amdgcn_sinf(r - floorf(r)); }
__device__ __forceinline__ float fcos_rev(float r) { return __builtin_amdgcn_cosf(r - floorf(r)); }
__device__ __forceinline__ float fsin(float x) { return fsin_rev(x * 0.15915494309189535f); }
__device__ __forceinline__ float wave_sum(float v) {
#pragma unroll
    for (int o = 1; o < 64; o <<= 1) v += __shfl_xor(v, o);
    return v;
}
__device__ __forceinline__ void lds_barrier() { asm volatile("s_waitcnt lgkmcnt(0)" ::: "memory"); __builtin_amdgcn_s_barrier(); asm volatile("" ::: "memory"); }
#define XB_TMO      128
#define XB_XCNT(j)  (256  + 64 * (j))
#define XB_XSUB(j)  (1280 + 64 * (j))
#define XB_XGEN(j)  (2304 + 64 * (j))
#define XB_TOP      3328
#define XB_TOPGEN   3392
#define XCD_BAR_WORDS 3456
#define XB_SPIN_CAP (1u << 18)
__device__ __forceinline__ unsigned xb_ld(unsigned* p)              { return __hip_atomic_load(p, __ATOMIC_RELAXED, __HIP_MEMORY_SCOPE_AGENT); }
__device__ __forceinline__ unsigned xb_add(unsigned* p, unsigned v) { return __hip_atomic_fetch_add(p, v, __ATOMIC_RELAXED, __HIP_MEMORY_SCOPE_AGENT); }
__device__ __forceinline__ unsigned xb_xcc_id() { return (unsigned)__builtin_amdgcn_s_getreg((3 << 11) | 20) & 0xFu; }
#define XB_SPIN(cond, bar) do { unsigned _sp = 0; while (cond) { __builtin_amdgcn_s_sleep(1); \
    if ((++_sp & 255u) == 0u) { if (xb_ld(&(bar)[XB_TMO])) break; if (_sp > XB_SPIN_CAP) { atomicAdd(&(bar)[XB_TMO], 1u); break; } } } } while (0)
struct XcdBarrier { unsigned* bar; unsigned x; volatile LAS unsigned* st; };
__device__ __forceinline__ XcdBarrier xcd_barrier_post(unsigned* bar, volatile LAS unsigned* st) {
    XcdBarrier b; b.bar = bar; b.x = xb_xcc_id(); b.st = st;
    if (threadIdx.x == 0) (void)xb_add(&bar[XB_XCNT(b.x)], 1u);
    return b;
}
__device__ __forceinline__ void xcd_barrier_complete(unsigned* bar, unsigned x, unsigned& nloc, unsigned& nx) {
    const unsigned G = gridDim.x * gridDim.y * gridDim.z;
    unsigned sum, cnt, mine, sp = 0u;
    for (;;) {
        sum = 0u; cnt = 0u; mine = 0u;
#pragma unroll
        for (unsigned j = 0; j < 16; ++j) { const unsigned c = xb_ld(&bar[XB_XCNT(j)]); sum += c; cnt += (c > 0u) ? 1u : 0u; mine = (j == x) ? c : mine; }
        if (sum == G) break;
        __builtin_amdgcn_s_sleep(1);
        if ((++sp & 255u) == 0u) { if (xb_ld(&bar[XB_TMO])) break; if (sp > XB_SPIN_CAP) { atomicAdd(&bar[XB_TMO], 1u); break; } }
    }
    nloc = mine > 0u ? mine : 1u; nx = cnt > 0u ? cnt : 1u;
}
__device__ __forceinline__ void xcd_barrier(const XcdBarrier& b) {
    asm volatile("s_waitcnt vmcnt(0)" ::: "memory");
    __syncthreads();
    if (threadIdx.x == 0) {
        unsigned* bar = b.bar;
        __builtin_amdgcn_s_waitcnt(0);
        unsigned nloc = b.st[0], nx = b.st[1];
        if (nloc == 0u) { xcd_barrier_complete(bar, b.x, nloc, nx); b.st[0] = nloc; b.st[1] = nx; }
        const unsigned old = xb_add(&bar[XB_XSUB(b.x)], 1u);
        const unsigned gen = old / nloc;
        if (old + 1u == (gen + 1u) * nloc) {
            __builtin_amdgcn_fence(__ATOMIC_RELEASE, "agent");
            asm volatile("s_waitcnt vmcnt(0)" ::: "memory");
            const unsigned og = xb_add(&bar[XB_TOP], 1u);
            const unsigned tg = og / nx;
            if (og + 1u == (tg + 1u) * nx) xb_add(&bar[XB_TOPGEN], 1u);
            else XB_SPIN(xb_ld(&bar[XB_TOPGEN]) == tg, bar);
            __builtin_amdgcn_fence(__ATOMIC_ACQUIRE, "agent");
            xb_add(&bar[XB_XGEN(b.x)], 1u);
            asm volatile("s_waitcnt vmcnt(0)" ::: "memory");
        } else {
            XB_SPIN(xb_ld(&bar[XB_XGEN(b.x)]) == gen, bar);
            __builtin_amdgcn_fence(__ATOMIC_ACQUIRE, "agent");
            asm volatile("s_waitcnt vmcnt(0)" ::: "memory");
        }
    }
    __syncthreads();
}

namespace pg8 {
constexpr int BM = 256, BK = 64, HALF = 128, HTB = HALF * BK * 2, STAGE_BYTES = 8 * HTB, NXCD = 8, WGM = 8;
__host__ __device__ __forceinline__ int lds_byte(int r, int c) { const int st = (r >> 4) * 2 + (c >> 5), rr = r & 15, cc = c & 31, ob = rr * 64 + cc * 2; return st * 1024 + (ob ^ (((ob >> 9) & 1) << 5)); }
__host__ __device__ __forceinline__ void stage_rc(int b, int& R, int& C) { const int st = b / 1024, sb = b % 1024, swz = sb ^ (((sb >> 9) & 1) << 5); R = (st >> 1) * 16 + swz / 64; C = (st & 1) * 32 + (swz % 64) / 2; }
__host__ __device__ __forceinline__ int perm32(int rho) { const int n = rho >> 4, i = rho & 15; return 8 * (i >> 2) + 4 * n + (i & 3); }
struct Unit { const char* A; const char* B; int pm, pn, kind; };
__device__ __forceinline__ void tile_of(int Lw, int nM, int nN, int& pm, int& pn) {
    const int nwg = nM * nN; int wgid = Lw; { const int q = nwg / NXCD, r = nwg % NXCD, xcd = wgid % NXCD, off = wgid / NXCD; wgid = (xcd < r ? xcd * (q + 1) : r * (q + 1) + (xcd - r) * q) + off; }
    const int nig = WGM * nN, gid = wgid / nig, fm = gid * WGM, gsz = (nM - fm) < WGM ? (nM - fm) : WGM;
    pm = fm + ((wgid % nig) % gsz); pn = (wgid % nig) / gsz;
}
typedef int i32x8 __attribute__((ext_vector_type(8)));
typedef int i32x4 __attribute__((ext_vector_type(4)));
__device__ __forceinline__ i32x8 cat8(bf16x8 a, bf16x8 b) { const i32x4 x = __builtin_bit_cast(i32x4, a), y = __builtin_bit_cast(i32x4, b); return (i32x8){x[0], x[1], x[2], x[3], y[0], y[1], y[2], y[3]}; }
__device__ __forceinline__ unsigned cvt_pk_bf16(float lo, float hi) { unsigned r; asm volatile("v_cvt_pk_bf16_f32 %0, %1, %2" : "=v"(r) : "v"(lo), "v"(hi)); return r; }

template <class Epi, class Sched, bool F8 = false>
__device__ __forceinline__ void gemm_phase(LAS unsigned char* lds, const int K, const Sched& S, const Epi& E, const int ntiles = 0) {
    int tid_ = threadIdx.x; asm volatile("" : "+v"(tid_));
    const int tid = tid_, wid = __builtin_amdgcn_readfirstlane(tid >> 6), lane = tid & 63, wr = wid >> 2, wc = wid & 3, fr = lane & 15, fq = lane >> 4;
    const int nt = ntiles ? ntiles : K / BK;
    unsigned voffA[2], voffB[2];
#pragma unroll
    for (int i = 0; i < 2; ++i) { int R, C; stage_rc(tid * 16 + i * 8192, R, C); const int Rb = Epi::PERM ? ((R & ~31) + perm32(R & 31)) : R;
        voffA[i] = (unsigned)(R * K + C) * 2u; voffB[i] = (unsigned)(Rb * K + C) * 2u; }
    const size_t kstep = (size_t)(BK * 2);
    const size_t hstep = (size_t)HALF * K * 2;
    const unsigned ldsw = (unsigned)wid * 1024u;
    const int aoff = lds_byte(wr * 64 + fr, fq * 8), boff = lds_byte(wc * 32 + fr, fq * 8);
#define PG8_SA(b, h) (((b) * 2 + (h)) * HTB)
#define PG8_SB(b, h) ((4 + (b) * 2 + (h)) * HTB)
#define PG8_STAGE(bufoff, gbase, voff) do { _Pragma("unroll") for (int _i = 0; _i < 2; ++_i) \
        __builtin_amdgcn_global_load_lds((const unsigned*)((const char*)(gbase) + (voff)[_i]), (LAS unsigned*)(lds + (bufoff) + ldsw + _i * 8192), 16, 0, 0); } while (0)
#define PG8_LDA(dst, b, h) do { if (F8) { _Pragma("unroll") for (int m = 0; m < 4; ++m) { const i32x4 lo_ = *(const LAS i32x4*)(lds + PG8_SA(b, h) + aoff + m * 2048), hi_ = *(const LAS i32x4*)(lds + PG8_SA(b, h) + aoff + m * 2048 + 1024); dst##8[m] = __builtin_shufflevector(lo_, hi_, 0, 1, 2, 3, 4, 5, 6, 7); } } \
        else { _Pragma("unroll") for (int m = 0; m < 4; ++m) _Pragma("unroll") for (int k = 0; k < 2; ++k) dst[m][k] = *(const LAS bf16x8*)(lds + PG8_SA(b, h) + aoff + m * 2048 + k * 1024); } } while (0)
#define PG8_LDB(dst, b, h) do { if (F8) { _Pragma("unroll") for (int n = 0; n < 2; ++n) { const i32x4 lo_ = *(const LAS i32x4*)(lds + PG8_SB(b, h) + boff + n * 2048), hi_ = *(const LAS i32x4*)(lds + PG8_SB(b, h) + boff + n * 2048 + 1024); dst##8[n] = __builtin_shufflevector(lo_, hi_, 0, 1, 2, 3, 4, 5, 6, 7); } } \
        else { _Pragma("unroll") for (int n = 0; n < 2; ++n) _Pragma("unroll") for (int k = 0; k < 2; ++k) dst[n][k] = *(const LAS bf16x8*)(lds + PG8_SB(b, h) + boff + n * 2048 + k * 1024); } } while (0)
#define PG8_MMA(ai, bj, At, Bt) do { if (F8) { __builtin_amdgcn_s_setprio(1); _Pragma("unroll") for (int m = 0; m < 4; ++m) _Pragma("unroll") for (int n = 0; n < 2; ++n) \
        asm volatile("v_mfma_scale_f32_16x16x128_f8f6f4 %0, %1, %2, %0, %3, %3 op_sel_hi:[0,0,0]" : "+v"(acc[ai][bj][m][n]) : "v"(Bt##8[n]), "v"(At##8[m]), "v"(f8one)); __builtin_amdgcn_s_setprio(0); } else PG8_MMA_BF(ai, bj, At, Bt); } while (0)
#define PG8_MMA_BF(ai, bj, At, Bt) do { __builtin_amdgcn_s_setprio(1); _Pragma("unroll") for (int m = 0; m < 4; ++m) _Pragma("unroll") for (int n = 0; n < 2; ++n) _Pragma("unroll") for (int k = 0; k < 2; ++k) \
        acc[ai][bj][m][n] = __builtin_amdgcn_mfma_f32_16x16x32_bf16(Bt[n][k], At[m][k], acc[ai][bj][m][n], 0, 0, 0); __builtin_amdgcn_s_setprio(0); } while (0)
#define PG8_WAIT_V(n) asm volatile("s_waitcnt vmcnt(" #n ")" ::: "memory")
#define PG8_WAIT_L(n) asm volatile("s_waitcnt lgkmcnt(" #n ")" ::: "memory")
#define PG8_BAR __builtin_amdgcn_s_barrier()
#define PG8_SCHED __builtin_amdgcn_sched_barrier(0)
    Unit cur, nxt; int ui = 0;
    if (!S.next(0, cur)) return;
    f32x4 acc[2][2][4][2];
#pragma unroll
    for (int a = 0; a < 2; ++a)
#pragma unroll
        for (int b = 0; b < 2; ++b)
#pragma unroll
            for (int m = 0; m < 4; ++m)
#pragma unroll
                for (int n = 0; n < 2; ++n) acc[a][b][m][n] = (f32x4){0.f, 0.f, 0.f, 0.f};
    int f8one = 0x7f7f7f7f; asm volatile("" : "+v"(f8one));
    bf16x8 At[4][2], B0[2][2], B1[2][2]; i32x8 At8[4], B08[2], B18[2];
    const char* cA = cur.A; const char* cB = cur.B;
    PG8_STAGE(PG8_SB(0, 0), cB, voffB); PG8_STAGE(PG8_SB(0, 1), cB + hstep, voffB); PG8_STAGE(PG8_SA(0, 0), cA, voffA); PG8_STAGE(PG8_SA(0, 1), cA + hstep, voffA);
    if (wr == 1) PG8_BAR;
    PG8_WAIT_V(2); PG8_BAR;
    PG8_STAGE(PG8_SB(1, 0), cB + kstep, voffB); PG8_STAGE(PG8_SA(1, 0), cA + kstep, voffA); PG8_STAGE(PG8_SB(1, 1), cB + hstep + kstep, voffB);
    PG8_WAIT_V(6); PG8_BAR;
    for (;;) {
        const bool has_next = S.next(ui + 1, nxt);
        const char* nA = has_next ? nxt.A : cA; const char* nB = has_next ? nxt.B : cB;
        for (int t = 0; t < nt; t += 2) {
            const bool last = (t == nt - 2);
            const char* a1 = cA + (size_t)(t + 1) * kstep;
            const char* a2 = last ? nA : cA + (size_t)(t + 2) * kstep; const char* b2 = last ? nB : cB + (size_t)(t + 2) * kstep;
            const char* a3 = a2 + kstep; const char* b3 = b2 + kstep;
            PG8_LDB(B0, 0, 0); PG8_LDB(B1, 0, 1); PG8_SCHED; PG8_LDA(At, 0, 0); PG8_STAGE(PG8_SA(1, 1), a1 + hstep, voffA);
            PG8_WAIT_V(8); PG8_WAIT_L(0); PG8_BAR; PG8_MMA(0, 0, At, B0); PG8_MMA(0, 1, At, B1); PG8_BAR; PG8_SCHED;
            PG8_LDA(At, 0, 1); PG8_STAGE(PG8_SB(0, 0), b2, voffB); PG8_STAGE(PG8_SB(0, 1), b2 + hstep, voffB); PG8_STAGE(PG8_SA(0, 0), a2, voffA);
            PG8_WAIT_V(8); PG8_WAIT_L(0); PG8_BAR; PG8_MMA(1, 0, At, B0); PG8_MMA(1, 1, At, B1); PG8_BAR; PG8_SCHED;
            PG8_LDB(B0, 1, 0); PG8_LDB(B1, 1, 1); PG8_SCHED; PG8_LDA(At, 1, 0); PG8_STAGE(PG8_SA(0, 1), a2 + hstep, voffA);
            PG8_WAIT_V(8); PG8_WAIT_L(0); PG8_BAR; PG8_MMA(0, 0, At, B0); PG8_MMA(0, 1, At, B1); PG8_BAR; PG8_SCHED;
            PG8_LDA(At, 1, 1); PG8_STAGE(PG8_SB(1, 0), b3, voffB); PG8_STAGE(PG8_SB(1, 1), b3 + hstep, voffB); PG8_STAGE(PG8_SA(1, 0), a3, voffA);
            PG8_WAIT_V(8); PG8_WAIT_L(0); PG8_BAR; PG8_MMA(1, 0, At, B0); PG8_MMA(1, 1, At, B1); PG8_BAR; PG8_SCHED;
        }
        if (wr == 0) PG8_BAR;
        if (F8) asm volatile("s_nop 15\n\ts_nop 15" ::: "memory");
        const bool keep = E(acc, cur, wr, wc, fr, fq);
        if (!has_next) break;
        if (!keep) {
#pragma unroll
        for (int a = 0; a < 2; ++a)
#pragma unroll
            for (int b = 0; b < 2; ++b)
#pragma unroll
                for (int m = 0; m < 4; ++m)
#pragma unroll
                    for (int n = 0; n < 2; ++n) acc[a][b][m][n] = (f32x4){0.f, 0.f, 0.f, 0.f};
        }
        cur = nxt; cA = nA; cB = nB; ++ui;
        if (wr == 1) PG8_BAR;
    }
    PG8_WAIT_V(0);
    PG8_BAR;
#undef PG8_SA
#undef PG8_SB
#undef PG8_STAGE
#undef PG8_LDA
#undef PG8_LDB
#undef PG8_MMA
#undef PG8_MMA_BF
#undef PG8_WAIT_V
#undef PG8_WAIT_L
#undef PG8_BAR
#undef PG8_SCHED
}
}
struct Ctx {
    float* out; unsigned char* ws; unsigned* ctl; LAS unsigned char* lds; volatile LAS unsigned* misc;
    int tid, lane, wave, G, bid;
    __device__ __forceinline__ const float* in(int i) const { const unsigned lo = __builtin_amdgcn_readfirstlane(misc[64 + 2 * i]), hi = __builtin_amdgcn_readfirstlane(misc[65 + 2 * i]);
        return (const float*)(const __attribute__((address_space(1))) float*)(((unsigned long long)hi << 32) | lo); }
};
__device__ __forceinline__ float rstd_of(const u64* sumsq, int row) { return __builtin_amdgcn_rsqf((float)sumsq[row] * SS_UNFIX + RMS_EPS); }

struct EpiWin {
    static constexpr bool PERM = true;
    bf16* uT; bf16* qkvr; bf16* sg; const u64* sumsq;
    __device__ __forceinline__ bool operator()(f32x4 (&acc)[2][2][4][2], const pg8::Unit& u, int wr, int wc, int fr, int fq) const {
        using namespace pg8;
        if (u.kind == 0) {
            const int col0 = u.pn * BM + wc * 32 + 8 * fq;
            f32x4 rs[2][2];
#pragma unroll
            for (int bj = 0; bj < 2; ++bj)
#pragma unroll
                for (int n = 0; n < 2; ++n) { const int c = col0 + bj * HALF + 4 * n;
                    rs[bj][n] = (f32x4){rstd_of(sumsq, c), rstd_of(sumsq, c + 1), rstd_of(sumsq, c + 2), rstd_of(sumsq, c + 3)}; }
#pragma unroll
            for (int ai = 0; ai < 2; ++ai)
#pragma unroll
                for (int m = 0; m < 4; ++m) { bf16* rowp = uT + (size_t)(u.pm * BM + ai * HALF + wr * 64 + m * 16 + fr) * L + col0;
#pragma unroll
                    for (int bj = 0; bj < 2; ++bj) { const f32x4 v0 = acc[ai][bj][m][0] * rs[bj][0], v1 = acc[ai][bj][m][1] * rs[bj][1];
                        v4u w; w.x = cvt_pk_bf16(v0[0], v0[1]); w.y = cvt_pk_bf16(v0[2], v0[3]); w.z = cvt_pk_bf16(v1[0], v1[1]); w.w = cvt_pk_bf16(v1[2], v1[3]);
                        *(v4u*)(rowp + bj * HALF) = w; } }
        } else {
            const int mode = u.pn < 8 ? 0 : (u.pn < 12 ? 1 : 2);
            bf16* base = u.pn < 12 ? qkvr + u.pn * BM : sg + (u.pn - 12) * BM; const int ld = u.pn < 12 ? 3072 : 4096;
            const int col0 = wc * 32 + 8 * fq;
            float rsv[2][4];
#pragma unroll
            for (int ai = 0; ai < 2; ++ai)
#pragma unroll
                for (int m = 0; m < 4; ++m) rsv[ai][m] = rstd_of(sumsq, u.pm * BM + ai * HALF + wr * 64 + m * 16 + fr);
#pragma unroll
            for (int ai = 0; ai < 2; ++ai)
#pragma unroll
                for (int m = 0; m < 4; ++m) { const int row = u.pm * BM + ai * HALF + wr * 64 + m * 16 + fr; const float rs = rsv[ai][m];
                    bf16* rowp = base + (size_t)row * ld + col0;
#pragma unroll
                    for (int bj = 0; bj < 2; ++bj) { f32x4 v0 = acc[ai][bj][m][0] * rs, v1 = acc[ai][bj][m][1] * rs;
                        if (mode == 1) {
#pragma unroll
                            for (int j = 0; j < 4; ++j) { v0[j] = fsilu(v0[j]); v1[j] = fsilu(v1[j]); } }
                        if (mode == 2) {
#pragma unroll
                            for (int j = 0; j < 4; ++j) { v0[j] = fsigmoid(v0[j]); v1[j] = fsigmoid(v1[j]); } }
                        v4u w; w.x = cvt_pk_bf16(v0[0], v0[1]); w.y = cvt_pk_bf16(v0[2], v0[3]); w.z = cvt_pk_bf16(v1[0], v1[1]); w.w = cvt_pk_bf16(v1[2], v1[3]);
                        *(v4u*)(rowp + bj * HALF) = w; } }
        }
        return false;
    }
};
struct SchedWin {
    int G, c; const char* WtHy; const char* WtRest; const char* xb;
    __device__ __forceinline__ bool next(int i, pg8::Unit& u) const {
        const int Lw = i * G + c; if (Lw >= 32 * 40) return false;
        int pm, pn; pg8::tile_of(Lw, 32, 40, pm, pn); const size_t ts = (size_t)256 * D * 2;
        if (pn < 12) { u.A = WtHy + pn * ts; u.B = xb + pm * ts; u.pm = pn; u.pn = pm; u.kind = 0; }
        else { u.A = xb + pm * ts; u.B = WtRest + (pn - 12) * ts; u.pm = pm; u.pn = pn - 12; u.kind = 1; }
        return true;
    }
};
struct SchedGrid {
    int G, c, nM, nN; const char* A; const char* B; size_t ts;
    __device__ __forceinline__ bool next(int i, pg8::Unit& u) const {
        const int Lw = i * G + c; if (Lw >= nM * nN) return false;
        int pm, pn; pg8::tile_of(Lw, nM, nN, pm, pn); u.A = A + pm * ts; u.B = B + pn * ts; u.pm = pm; u.pn = pn; u.kind = 0; return true;
    }
};
struct EpiBranch {
    static constexpr bool PERM = true;
    const bf16* sg; bf16* mixed;
    __device__ __forceinline__ bool operator()(f32x4 (&acc)[2][2][4][2], const pg8::Unit& u, int wr, int wc, int fr, int fq) const {
        using namespace pg8;
        const int col0 = u.pn * BM + wc * 32 + 8 * fq;
        if (u.kind == 0) {
#pragma unroll
            for (int ai = 0; ai < 2; ++ai) { v4u ga[4][2], gb[4][2];
#pragma unroll
                for (int m = 0; m < 4; ++m)
#pragma unroll
                    for (int bj = 0; bj < 2; ++bj) { const size_t o = (size_t)(u.pm * BM + ai * HALF + wr * 64 + m * 16 + fr) * 4096 + col0 + bj * HALF; ga[m][bj] = *(const v4u*)(sg + o); gb[m][bj] = *(const v4u*)(sg + o + 2048); }
#pragma unroll
                for (int m = 0; m < 4; ++m)
#pragma unroll
                    for (int bj = 0; bj < 2; ++bj) { const v4u a4 = ga[m][bj], b4 = gb[m][bj];
                        const float a[8] = {bf2f(a4.x & 0xffffu), bf2f(a4.x >> 16), bf2f(a4.y & 0xffffu), bf2f(a4.y >> 16), bf2f(a4.z & 0xffffu), bf2f(a4.z >> 16), bf2f(a4.w & 0xffffu), bf2f(a4.w >> 16)};
                        const float b[8] = {bf2f(b4.x & 0xffffu), bf2f(b4.x >> 16), bf2f(b4.y & 0xffffu), bf2f(b4.y >> 16), bf2f(b4.z & 0xffffu), bf2f(b4.z >> 16), bf2f(b4.w & 0xffffu), bf2f(b4.w >> 16)};
#pragma unroll
                        for (int j = 0; j < 4; ++j) { acc[ai][bj][m][0][j] *= a[j] * __builtin_amdgcn_rcpf(b[j]); acc[ai][bj][m][1][j] *= a[4 + j] * __builtin_amdgcn_rcpf(b[4 + j]); } } }
            return true;
        }
#pragma unroll
        for (int ai = 0; ai < 2; ++ai) { v4u gb[4][2];
#pragma unroll
            for (int m = 0; m < 4; ++m)
#pragma unroll
                for (int bj = 0; bj < 2; ++bj) gb[m][bj] = *(const v4u*)(sg + (size_t)(u.pm * BM + ai * HALF + wr * 64 + m * 16 + fr) * 4096 + 2048 + col0 + bj * HALF);
#pragma unroll
            for (int m = 0; m < 4; ++m)
#pragma unroll
                for (int bj = 0; bj < 2; ++bj) { const v4u b4 = gb[m][bj];
                    const float b[8] = {bf2f(b4.x & 0xffffu), bf2f(b4.x >> 16), bf2f(b4.y & 0xffffu), bf2f(b4.y >> 16), bf2f(b4.z & 0xffffu), bf2f(b4.z >> 16), bf2f(b4.w & 0xffffu), bf2f(b4.w >> 16)};
                    f32x4 v0 = acc[ai][bj][m][0], v1 = acc[ai][bj][m][1];
#pragma unroll
                    for (int j = 0; j < 4; ++j) { v0[j] *= b[j]; v1[j] *= b[4 + j]; }
                    v4u w; w.x = cvt_pk_bf16(v0[0], v0[1]); w.y = cvt_pk_bf16(v0[2], v0[3]); w.z = cvt_pk_bf16(v1[0], v1[1]); w.w = cvt_pk_bf16(v1[2], v1[3]);
                    *(v4u*)(mixed + (size_t)(u.pm * BM + ai * HALF + wr * 64 + m * 16 + fr) * D + col0 + bj * HALF) = w; } }
        return false;
    }
};
struct SchedBranch {
    int G, c; const char* hy; const char* gla; const char* WaT; const char* WbT;
    __device__ __forceinline__ bool next(int i, pg8::Unit& u) const {
        const int Lw = (i >> 1) * G + c; if (Lw >= 32 * 8) return false;
        int pm, pn; pg8::tile_of(Lw, 32, 8, pm, pn); const size_t ts = (size_t)256 * 1024 * 2;
        u.pm = pm; u.pn = pn; u.kind = i & 1;
        if ((i & 1) == 0) { u.A = hy + pm * ts; u.B = WaT + pn * ts; } else { u.A = gla + pm * ts; u.B = WbT + pn * ts; }
        return true;
    }
};
template <int XO> struct EpiResid {
    static constexpr bool PERM = true;
    const float* base; float* xres; bf16* xb; u64* sumsq;
    __device__ __forceinline__ bool operator()(f32x4 (&acc)[2][2][4][2], const pg8::Unit& u, int wr, int wc, int fr, int fq) const {
        using namespace pg8;
        const int col0 = u.pn * BM + wc * 32 + 8 * fq;
#pragma unroll
        for (int ai = 0; ai < 2; ++ai) { f32x4 bv[4][2][2];
#pragma unroll
            for (int m = 0; m < 4; ++m)
#pragma unroll
                for (int bj = 0; bj < 2; ++bj)
#pragma unroll
                    for (int n = 0; n < 2; ++n) bv[m][bj][n] = *(const f32x4*)(base + (size_t)(u.pm * BM + ai * HALF + wr * 64 + m * 16 + fr) * D + col0 + bj * HALF + 4 * n);
            asm volatile("" ::: "memory");
#pragma unroll
            for (int m = 0; m < 4; ++m) { const int row = u.pm * BM + ai * HALF + wr * 64 + m * 16 + fr; const size_t off = (size_t)row * D + col0; float s = 0.f;
#pragma unroll
                for (int bj = 0; bj < 2; ++bj) { const size_t o = off + bj * HALF; const f32x4 v0 = bv[m][bj][0] + acc[ai][bj][m][0], v1 = bv[m][bj][1] + acc[ai][bj][m][1];
                    *(f32x4*)(xres + o) = v0; *(f32x4*)(xres + o + 4) = v1;
                    if (XO == 0) { v4u w; w.x = cvt_pk_bf16(v0[0], v0[1]); w.y = cvt_pk_bf16(v0[2], v0[3]); w.z = cvt_pk_bf16(v1[0], v1[1]); w.w = cvt_pk_bf16(v1[2], v1[3]); *(v4u*)(xb + o) = w; }
                    if (XO == 1) { *(v2u*)((unsigned char*)xb + o) = (v2u){f8pack4(v0[0] * F8_ASCALE, v0[1] * F8_ASCALE, v0[2] * F8_ASCALE, v0[3] * F8_ASCALE), f8pack4(v1[0] * F8_ASCALE, v1[1] * F8_ASCALE, v1[2] * F8_ASCALE, v1[3] * F8_ASCALE)}; }
                    s += (v0[0] * v0[0] + v0[1] * v0[1]) + (v0[2] * v0[2] + v0[3] * v0[3]); s += (v1[0] * v1[0] + v1[1] * v1[1]) + (v1[2] * v1[2] + v1[3] * v1[3]); }
                s += __shfl_xor(s, 16); s += __shfl_xor(s, 32);
                if (fq == 0) atomicAdd(sumsq + row, (u64)(s * SS_FIX)); } }
        return false;
    }
};
template <bool O8> struct EpiSwigluT {
    static constexpr bool PERM = true;
    bf16* act; const u64* sumsq; const float* rowscale; float mul;
    __device__ __forceinline__ bool operator()(f32x4 (&acc)[2][2][4][2], const pg8::Unit& u, int wr, int wc, int fr, int fq) const {
        using namespace pg8;
        const int col0 = u.pn * HALF + wc * 32 + 8 * fq;
        float rsv[2][4];
        if (sumsq) {
#pragma unroll
            for (int ai = 0; ai < 2; ++ai)
#pragma unroll
                for (int m = 0; m < 4; ++m) rsv[ai][m] = rstd_of(sumsq, u.pm * BM + ai * HALF + wr * 64 + m * 16 + fr) * mul;
        } else {
#pragma unroll
            for (int ai = 0; ai < 2; ++ai)
#pragma unroll
                for (int m = 0; m < 4; ++m) rsv[ai][m] = rowscale[u.pm * BM + ai * HALF + wr * 64 + m * 16 + fr];
        }
#pragma unroll
        for (int ai = 0; ai < 2; ++ai)
#pragma unroll
            for (int m = 0; m < 4; ++m) { const int row = u.pm * BM + ai * HALF + wr * 64 + m * 16 + fr; const float rs = rsv[ai][m];
                float o[8];
#pragma unroll
                for (int n = 0; n < 2; ++n)
#pragma unroll
                    for (int j = 0; j < 4; ++j) { const float g = acc[ai][0][m][n][j] * rs, up = acc[ai][1][m][n][j] * rs; o[4 * n + j] = fsilu(g) * up; }
                v4u w; w.x = cvt_pk_bf16(o[0], o[1]); w.y = cvt_pk_bf16(o[2], o[3]); w.z = cvt_pk_bf16(o[4], o[5]); w.w = cvt_pk_bf16(o[6], o[7]);
                if (O8) *(v2u*)((unsigned char*)act + (size_t)row * FF + col0) = (v2u){f8pack4(o[0] * F8_ACTSCALE, o[1] * F8_ACTSCALE, o[2] * F8_ACTSCALE, o[3] * F8_ACTSCALE), f8pack4(o[4] * F8_ACTSCALE, o[5] * F8_ACTSCALE, o[6] * F8_ACTSCALE, o[7] * F8_ACTSCALE)};
                else *(v4u*)(act + (size_t)row * FF + col0) = w; }
        return false;
    }
};
typedef EpiSwigluT<false> EpiSwiglu;
struct EpiMoeDown {
    static constexpr bool PERM = true;
    bf16* ys; const float* rowgate;
    __device__ __forceinline__ bool operator()(f32x4 (&acc)[2][2][4][2], const pg8::Unit& u, int wr, int wc, int fr, int fq) const {
        using namespace pg8;
        const int col0 = u.pn * BM + wc * 32 + 8 * fq;
        float gv[2][4];
#pragma unroll
        for (int ai = 0; ai < 2; ++ai)
#pragma unroll
            for (int m = 0; m < 4; ++m) gv[ai][m] = rowgate[u.pm * BM + ai * HALF + wr * 64 + m * 16 + fr];
#pragma unroll
        for (int ai = 0; ai < 2; ++ai)
#pragma unroll
            for (int m = 0; m < 4; ++m) { const int row = u.pm * BM + ai * HALF + wr * 64 + m * 16 + fr; const float g = gv[ai][m];
#pragma unroll
                for (int bj = 0; bj < 2; ++bj) { const f32x4 v0 = acc[ai][bj][m][0] * g, v1 = acc[ai][bj][m][1] * g;
                    v4u w; w.x = cvt_pk_bf16(v0[0], v0[1]); w.y = cvt_pk_bf16(v0[2], v0[3]); w.z = cvt_pk_bf16(v1[0], v1[1]); w.w = cvt_pk_bf16(v1[2], v1[3]);
                    *(v4u*)(ys + (size_t)row * D + col0 + bj * HALF) = w; } }
        return false;
    }
};
struct SchedMoe {
    int G, c, ncol, limit; const char* A; const char* W; size_t ts, wstride; volatile LAS unsigned* misc;
    __device__ __forceinline__ bool next(int i, pg8::Unit& u) const {
        int Lw = i * G + c; if (Lw >= limit) return false;
#pragma unroll 1
        for (int e = 0; e < NE; ++e) { const int nt = (int)misc[16 + e], nu = nt * ncol;
            if (Lw < nu) { const int pn = Lw / nt, rt = Lw - pn * nt, tile = (int)misc[24 + e] + rt;
                u.A = A + (size_t)tile * ts; u.B = W + (size_t)e * wstride + (size_t)pn * ts; u.pm = tile; u.pn = pn; u.kind = e; return true; }
            Lw -= nu; }
        return false;
    }
};
__device__ __forceinline__ int moe_split_tiles(int S, int slice) { return S == 4 ? ((slice & 1) ? 10 : 12) : 22; }
struct SchedMoeSplit {
    int c; const char* A; const char* W; size_t ts, wstride; volatile LAS unsigned* misc;
    __device__ __forceinline__ bool next(int i, pg8::Unit& u) const {
        const int S = (int)misc[33], urem = (int)misc[34]; if (i > 0 || c >= urem * S) return false;
        const int uidx = c / S, slice = c - uidx * S; int Lw = (int)misc[32] + uidx;
#pragma unroll 1
        for (int e = 0; e < NE; ++e) { const int nt = (int)misc[16 + e], nu = nt * 8;
            if (Lw < nu) { const int pn = Lw / nt, rt = Lw - pn * nt, tile = (int)misc[24 + e] + rt; const size_t ko = (size_t)(S == 4 ? 22 * (slice >> 1) + 12 * (slice & 1) : 22 * slice) * 128;
                u.A = A + (size_t)tile * ts + ko; u.B = W + (size_t)e * wstride + (size_t)pn * ts + ko; u.pm = c; u.pn = tile; u.kind = e; return true; }
            Lw -= nu; }
        return false;
    }
};
struct EpiMoeDownSplit {
    static constexpr bool PERM = false;
    float* slab; const float* rowgate;
    __device__ __forceinline__ bool operator()(f32x4 (&acc)[2][2][4][2], const pg8::Unit& u, int wr, int wc, int fr, int fq) const {
        using namespace pg8;
        float* base = slab + (size_t)u.pm * 65536 + wc * 32 + 4 * fq;
#pragma unroll
        for (int ai = 0; ai < 2; ++ai)
#pragma unroll
            for (int m = 0; m < 4; ++m) { const int lr = ai * HALF + wr * 64 + m * 16 + fr; const float g = rowgate[u.pn * BM + lr];
#pragma unroll
                for (int bj = 0; bj < 2; ++bj)
#pragma unroll
                    for (int n = 0; n < 2; ++n) *(f32x4*)(base + lr * 256 + bj * HALF + n * 16) = acc[ai][bj][m][n] * g; }
        return false;
    }
};
struct EpiBf16Plain {
    static constexpr bool PERM = true;
    bf16* C; int ldc;
    __device__ __forceinline__ bool operator()(f32x4 (&acc)[2][2][4][2], const pg8::Unit& u, int wr, int wc, int fr, int fq) const {
        using namespace pg8;
        const int col0 = u.pn * BM + wc * 32 + 8 * fq;
#pragma unroll
        for (int ai = 0; ai < 2; ++ai)
#pragma unroll
            for (int m = 0; m < 4; ++m) { bf16* rowp = C + (size_t)(u.pm * BM + ai * HALF + wr * 64 + m * 16 + fr) * ldc + col0;
#pragma unroll
                for (int bj = 0; bj < 2; ++bj) { const f32x4 v0 = acc[ai][bj][m][0], v1 = acc[ai][bj][m][1];
                    v4u w; w.x = cvt_pk_bf16(v0[0], v0[1]); w.y = cvt_pk_bf16(v0[2], v0[3]); w.z = cvt_pk_bf16(v1[0], v1[1]); w.w = cvt_pk_bf16(v1[2], v1[3]);
                    *(v4u*)(rowp + bj * HALF) = w; } }
        return false;
    }
};
struct EpiF32 {
    static constexpr bool PERM = false;
    float* C; int ldc;
    __device__ __forceinline__ bool operator()(f32x4 (&acc)[2][2][4][2], const pg8::Unit& u, int wr, int wc, int fr, int fq) const {
        using namespace pg8;
        const int col0 = u.pn * BM + wc * 32 + 4 * fq;
#pragma unroll
        for (int ai = 0; ai < 2; ++ai)
#pragma unroll
            for (int m = 0; m < 4; ++m) { float* rowp = C + (size_t)(u.pm * BM + ai * HALF + wr * 64 + m * 16 + fr) * ldc + col0;
#pragma unroll
                for (int bj = 0; bj < 2; ++bj)
#pragma unroll
                    for (int n = 0; n < 2; ++n) *(f32x4*)(rowp + bj * HALF + n * 16) = acc[ai][bj][m][n]; }
        return false;
    }
};
struct TrItem { const float* W; bf16* dst; const float* kscale; int N, ldk, k0, f8; };
__device__ __forceinline__ void tr_load(const TrItem& d, int lane, f32x4 (&v)[16]) {
    const int kk = lane >> 4, q = lane & 15;
#pragma unroll
    for (int i = 0; i < 16; ++i) v[i] = __builtin_nontemporal_load((const f32x4*)(d.W + (size_t)(d.k0 + 4 * i + kk) * d.N + 4 * q));
}
typedef short s16x4 __attribute__((ext_vector_type(4)));
__device__ __forceinline__ void tr_store_f8(const TrItem& d, int lane, const f32x4 (&v)[16], LAS float* scr_) {
    LAS unsigned char* scr = (LAS unsigned char*)scr_;
    const int kk = lane >> 4, q = lane & 15;
#pragma unroll
    for (int i = 0; i < 16; ++i) { const int k = 4 * i + kk; const float s = (d.kscale ? d.kscale[d.k0 + k] : 1.0f) * F8_WSCALE;
        v2u w; w.x = pg8::cvt_pk_bf16(v[i][0] * s, v[i][1] * s); w.y = pg8::cvt_pk_bf16(v[i][2] * s, v[i][3] * s); *(LAS v2u*)(scr + k * 160 + q * 8) = w; }
    LDS_WAIT(); asm volatile("" ::: "memory");
    const int g = lane >> 4, i = lane & 15, qq = i >> 2, p = i & 3, par = g & 1;
#pragma unroll
    for (int nb = 0; nb < 4; ++nb) { v2u r[4];
#pragma unroll
        for (int t = 0; t < 4; ++t) r[t] = __builtin_bit_cast(v2u, __builtin_amdgcn_ds_read_tr16_b64_v4i16((LAS s16x4*)(scr + (16 * g + 4 * (t ^ par) + qq) * 160 + (16 * nb + 4 * p) * 2)));
        unsigned o[4];
#pragma unroll
        for (int h = 0; h < 2; ++h) { const v2u lo = par ? r[2 * h + 1] : r[2 * h], hi = par ? r[2 * h] : r[2 * h + 1];
            int w0 = 0, w1 = 0;
            w0 = __builtin_amdgcn_cvt_pk_fp8_f32(bf2f(lo.x & 0xffffu), bf2f(lo.x >> 16), w0, false); w0 = __builtin_amdgcn_cvt_pk_fp8_f32(bf2f(lo.y & 0xffffu), bf2f(lo.y >> 16), w0, true);
            w1 = __builtin_amdgcn_cvt_pk_fp8_f32(bf2f(hi.x & 0xffffu), bf2f(hi.x >> 16), w1, false); w1 = __builtin_amdgcn_cvt_pk_fp8_f32(bf2f(hi.y & 0xffffu), bf2f(hi.y >> 16), w1, true);
            o[2 * h] = (unsigned)w0; o[2 * h + 1] = (unsigned)w1; }
        *(v4u*)((unsigned char*)d.dst + (size_t)(16 * nb + i) * d.ldk + d.k0 + 16 * g) = (v4u){o[0], o[1], o[2], o[3]}; }
    LDS_WAIT(); asm volatile("" ::: "memory");
}
__device__ __forceinline__ void tr_store(const TrItem& d, int lane, const f32x4 (&v)[16], LAS float* scr) {
    if (d.f8) { tr_store_f8(d, lane, v, scr); return; }
    const int kk = lane >> 4, q = lane & 15;
#pragma unroll
    for (int i = 0; i < 16; ++i) { const int k = 4 * i + kk; const float s = d.kscale ? d.kscale[d.k0 + k] : 1.0f;
        scr[k * 65 + 4 * q + 0] = v[i][0] * s; scr[k * 65 + 4 * q + 1] = v[i][1] * s; scr[k * 65 + 4 * q + 2] = v[i][2] * s; scr[k * 65 + 4 * q + 3] = v[i][3] * s; }
    LDS_WAIT(); asm volatile("" ::: "memory");
    const int nn = lane & 7, c = lane >> 3;
#pragma unroll
    for (int it = 0; it < 8; ++it) { const int n = 8 * it + nn; const LAS float* s = scr + (8 * c) * 65 + n;
        v4u o; o.x = pk2(s[0 * 65], s[1 * 65]); o.y = pk2(s[2 * 65], s[3 * 65]); o.z = pk2(s[4 * 65], s[5 * 65]); o.w = pk2(s[6 * 65], s[7 * 65]);
        if (d.f8) { int lo = 0, hi = 0;
            lo = __builtin_amdgcn_cvt_pk_fp8_f32(s[0 * 65] * F8_WSCALE, s[1 * 65] * F8_WSCALE, lo, false); lo = __builtin_amdgcn_cvt_pk_fp8_f32(s[2 * 65] * F8_WSCALE, s[3 * 65] * F8_WSCALE, lo, true);
            hi = __builtin_amdgcn_cvt_pk_fp8_f32(s[4 * 65] * F8_WSCALE, s[5 * 65] * F8_WSCALE, hi, false); hi = __builtin_amdgcn_cvt_pk_fp8_f32(s[6 * 65] * F8_WSCALE, s[7 * 65] * F8_WSCALE, hi, true);
            *(v2u*)((unsigned char*)d.dst + (size_t)n * d.ldk + d.k0 + 8 * c) = (v2u){(unsigned)lo, (unsigned)hi}; }
        else *(v4u*)(d.dst + (size_t)n * d.ldk + d.k0 + 8 * c) = o; }
    LDS_WAIT(); asm volatile("" ::: "memory");
}
constexpr int IT_WIN = 2 * 32 * 160, IT_WAB = 2 * 2 * 16 * 32, IT_WOUT = 2 * 32 * 32, IT_GU = 9 * 2 * 32 * 88, IT_DN = 9 * 88 * 32;
constexpr int IT_TOTAL = IT_WIN + IT_WAB + IT_WOUT + IT_GU + IT_DN;
__device__ __forceinline__ void item_desc(const Ctx& X, int r, TrItem& d) {
    unsigned char* ws = X.ws;
    if (r < IT_WIN) {
        const int l = r / (32 * 160); r -= l * 32 * 160; const int kt = r / 160, nt = r % 160;
        const float* W = X.in(I_W_IN) + (size_t)l * D * PIN; int col;
        if (nt < 48) { col = 64 * nt; d.dst = (bf16*)(ws + WS_W + l * W_LAYER + W_HY) + (size_t)(64 * nt) * D; }
        else if (nt < 96) { col = 64 * nt; d.dst = (bf16*)(ws + WS_W + l * W_LAYER + W_REST) + (size_t)(64 * (nt - 48)) * D; }
        else { col = C_GA + 64 * (nt - 96); d.dst = (bf16*)(ws + WS_W + l * W_LAYER + W_REST) + (size_t)(3072 + 64 * (nt - 96)) * D; }
        d.W = W + col; d.N = PIN; d.ldk = D; d.k0 = 64 * kt; d.kscale = X.in(I_NORM_MIX) + l * D; d.f8 = 0; return; }
    r -= IT_WIN;
    if (r < IT_WAB) {
        const int l = r / (2 * 16 * 32); r -= l * 2 * 16 * 32; const int ab = r / (16 * 32); r -= ab * 16 * 32; const int kt = r / 32, nt = r % 32;
        d.W = X.in(ab ? I_WB : I_WA) + (size_t)l * 1024 * D + 64 * nt; d.dst = (bf16*)(ws + WS_W + l * W_LAYER + (ab ? W_B : W_A)) + (size_t)(64 * nt) * 1024;
        d.N = D; d.ldk = 1024; d.k0 = 64 * kt; d.kscale = nullptr; d.f8 = 0; return; }
    r -= IT_WAB;
    if (r < IT_WOUT) {
        const int l = r / (32 * 32); r -= l * 32 * 32; const int kt = r / 32, nt = r % 32;
        d.W = X.in(I_WOUT) + (size_t)l * D * D + 64 * nt; d.dst = (bf16*)(ws + WS_W + l * W_LAYER + W_O) + (size_t)(64 * nt) * D; d.N = D; d.ldk = D; d.k0 = 64 * kt; d.kscale = nullptr; d.f8 = 0; return; }
    r -= IT_WOUT;
    if (r < IT_GU) {
        const int f = r / (2 * 32 * 88); r -= f * 2 * 32 * 88; const int gu = r / (32 * 88); r -= gu * 32 * 88; const int kt = r / 88, nt = r % 88;
        const float* W = f == 0 ? X.in(gu ? I_DWU : I_DWG) : X.in(gu ? I_MWU : I_MWG) + (size_t)(f - 1) * D * FF;
        const int n0 = 64 * nt, drow = 256 * (n0 >> 7) + 128 * gu + (n0 & 127);
        d.W = W + n0; d.N = FF; d.ldk = D; d.k0 = 64 * kt;
        d.dst = (bf16*)(ws + WS_WFF + (size_t)f * W_FFN + W_GU + (size_t)drow * D); d.kscale = f == 0 ? X.in(I_NORM_FFN) : nullptr; d.f8 = 1;
        return; }
    r -= IT_GU;
    {
        const int f = r / (88 * 32); r -= f * 88 * 32; const int kt = r / 32, nt = r % 32;
        const float* W = f == 0 ? X.in(I_DWD) : X.in(I_MWD) + (size_t)(f - 1) * FF * D;
        d.W = W + 64 * nt; d.N = D; d.ldk = FF; d.k0 = 64 * kt; d.kscale = nullptr;
        d.f8 = f != 0; d.dst = (bf16*)(ws + WS_WFF + (size_t)f * W_FFN + W_DT + (size_t)(64 * nt) * FF * (f == 0 ? 2 : 1)); }
}
__device__ __forceinline__ void p0_weights(const Ctx& X, int lo, int hi) {
    LAS float* scr = (LAS float*)(X.lds + X.wave * 16640);
    const int gw = X.bid * 8 + X.wave, NGW = X.G * 8;
    const int first = lo + gw; if (first >= hi) return;
    const int last = first + ((hi - 1 - first) / NGW) * NGW;
    TrItem da, db; f32x4 va[16], vb[16];
    item_desc(X, first, da); tr_load(da, X.lane, va);
#pragma unroll 1
    for (int it = first; ; it += 2 * NGW) {
        { const int nx = it + NGW; item_desc(X, nx < last ? nx : last, db); tr_load(db, X.lane, vb); }
        tr_store(da, X.lane, va, scr);
        if (it + NGW > last) break;
        { const int nx = it + 2 * NGW; item_desc(X, nx < last ? nx : last, da); tr_load(da, X.lane, va); }
        tr_store(db, X.lane, vb, scr);
        if (it + 2 * NGW > last) break;
    }
}
template <int PART> __device__ __forceinline__ void p0_misc(const Ctx& X) {
    unsigned char* ws = X.ws; const int gt = X.bid * 512 + X.tid, NGT = X.G * 512;
    if (PART == 1) {
    { const float* win = X.in(I_W_IN); const float* nm = X.in(I_NORM_MIX);
    for (int i = gt; i < 2 * 32 * D; i += NGT) { const int l = i / (32 * D), j = (i / D) % 32, k = i % D;
        ((bf16*)(ws + WS_W + l * W_LAYER + W_LR))[(size_t)j * D + k] = (bf16)f2bf(win[(size_t)l * D * PIN + (size_t)k * PIN + C_LR + j] * nm[l * D + k]); } }
    }
    if (PART == 0) {
    const float* fw4 = X.in(I_FW4);
    for (int i = gt; i < 2 * 32 * 4096; i += NGT) { const int c = i % 4096, q = (i / 4096) % 32, l = i / (32 * 4096);
        v4u o = (v4u){0u, 0u, 0u, 0u};
        if (q < 8) { const float* w = fw4 + (size_t)l * 64 * 4096 + (size_t)(8 * q) * 4096 + c;
            o.x = pk2(w[0], w[4096]); o.y = pk2(w[2 * 4096], w[3 * 4096]); o.z = pk2(w[4 * 4096], w[5 * 4096]); o.w = pk2(w[6 * 4096], w[7 * 4096]); }
        *(v4u*)((bf16*)(ws + WS_W4T) + ((size_t)l * 4096 + c) * 256 + 8 * q) = o; }
    }
    if (PART == 1) {
    for (int i = gt; i < NFFT; i += NGT) { float s, c; sincospif((float)i * (1.0f / 8192.0f), &s, &c); ((f32x2*)(ws + WS_TW))[i] = (f32x2){c, -s}; }
    { const int gw = X.bid * 8 + X.wave, NGW = X.G * 8; u64* sumsq = (u64*)(X.ctl + CW_SUMSQ);
      const float* xin = X.in(I_X);
      for (int m = gw; m < L; m += NGW) { const f32x4* xr = (const f32x4*)(xin + (size_t)m * D) + X.lane; v2u* o8 = (v2u*)((bf16*)(ws + WS_XB) + (size_t)m * D) + X.lane; float s = 0.f;
#pragma unroll
          for (int j = 0; j < 8; ++j) { const f32x4 v = xr[64 * j]; s += (v[0] * v[0] + v[1] * v[1]) + (v[2] * v[2] + v[3] * v[3]); v2u w; w.x = pk2(v[0], v[1]); w.y = pk2(v[2], v[3]); o8[64 * j] = w; }
          s = wave_sum(s); if (X.lane == 0) sumsq[m] = (u64)(s * SS_FIX); } }
    }
    if (PART == 0) {
    { const int gw = X.bid * 8 + X.wave, NGW = X.G * 8; LAS float* zs = (LAS float*)(X.lds + 140 * 1024) + X.wave * 64;
      const float* fw1 = X.in(I_FW1); const float* fw2 = X.in(I_FW2); const float* fw3 = X.in(I_FW3); const float* fb1 = X.in(I_FB1); const float* fb2 = X.in(I_FB2); const float* fb3 = X.in(I_FB3);
      const float* ff1 = X.in(I_FF1); const float* ff2 = X.in(I_FF2); const float* ff3 = X.in(I_FF3);
#pragma unroll 1
      for (int l = 0; l < 2; ++l) { const int j = X.lane;
        float w1[33], w2[64], w3[64];
#pragma unroll
        for (int i = 0; i < 33; ++i) w1[i] = fw1[(size_t)l * 33 * 64 + i * 64 + j];
#pragma unroll
        for (int i = 0; i < 64; ++i) { w2[i] = fw2[(size_t)l * 64 * 64 + i * 64 + j]; w3[i] = fw3[(size_t)l * 64 * 64 + i * 64 + j]; }
        const float c1 = fb1[l * 64 + j], c2 = fb2[l * 64 + j], c3 = fb3[l * 64 + j], q1 = ff1[l * 64 + j], q2 = ff2[l * 64 + j], q3 = ff3[l * 64 + j];
#pragma unroll 1
        for (int t = gw; t < L; t += NGW) {
          { const float tn = (float)t / (float)(L - 1), om = 6.283185307179586f * (float)t / (float)L; float z = 0.f;
            if (j == 0) z = tn;
            else if (j <= 32) { const int b = (j - 1) & 15; const float band = 1e-4f + (float)b * ((15.0f - 1e-4f) / 15.0f); const float a = band * om, rv = a * 0.15915494309189535f;
                z = j <= 16 ? fcos_rev(rv) : -fsin_rev(rv); }
            zs[j] = z; }
          LDS_WAIT(); asm volatile("" ::: "memory");
          float a = c1;
#pragma unroll
          for (int i = 0; i < 32; i += 4) { const f32x4 z4 = *(const LAS f32x4*)(zs + i); a += z4[0] * w1[i]; a += z4[1] * w1[i + 1]; a += z4[2] * w1[i + 2]; a += z4[3] * w1[i + 3]; }
          a += zs[32] * w1[32];
          float h = fsin(q1 * a);
          LDS_WAIT(); asm volatile("" ::: "memory"); zs[j] = h; LDS_WAIT(); asm volatile("" ::: "memory");
          a = c2;
#pragma unroll
          for (int i = 0; i < 64; i += 4) { const f32x4 z4 = *(const LAS f32x4*)(zs + i); a += z4[0] * w2[i]; a += z4[1] * w2[i + 1]; a += z4[2] * w2[i + 2]; a += z4[3] * w2[i + 3]; }
          h = fsin(q2 * a);
          LDS_WAIT(); asm volatile("" ::: "memory"); zs[j] = h; LDS_WAIT(); asm volatile("" ::: "memory");
          a = c3;
#pragma unroll
          for (int i = 0; i < 64; i += 4) { const f32x4 z4 = *(const LAS f32x4*)(zs + i); a += z4[0] * w3[i]; a += z4[1] * w3[i + 1]; a += z4[2] * w3[i + 2]; a += z4[3] * w3[i + 3]; }
          h = fsin(q3 * a);
          LDS_WAIT(); asm volatile("" ::: "memory");
          bf16* o = (bf16*)(ws + WS_H3B) + ((size_t)l * L + t) * 256; o[j] = (bf16)f2bf(h); o[64 + j] = 0; o[128 + j] = 0; o[192 + j] = 0; } } }
    }
}
#ifdef FFT_HOST
#define FFT_HD inline
#define FFT_LAS
typedef struct { float x, y; } cpxv;
static inline float FADD(float a, float b) { return a + b; }
static inline float FSUB(float a, float b) { return a - b; }
static inline float FMUL(float a, float b) { return a * b; }
static inline float FFMA(float a, float b, float c) { return a * b + c; }
static inline float FFMS(float a, float b, float c) { return a * b - c; }
static inline float FNMA(float a, float b, float c) { return c - a * b; }
#else
#define FFT_HD __device__ __forceinline__
#define FFT_LAS LAS
typedef float cpxv __attribute__((ext_vector_type(2)));
__device__ __forceinline__ float FADD(float a, float b) { float r; asm("v_add_f32 %0, %1, %2" : "=v"(r) : "v"(a), "v"(b)); return r; }
__device__ __forceinline__ float FSUB(float a, float b) { float r; asm("v_sub_f32 %0, %1, %2" : "=v"(r) : "v"(a), "v"(b)); return r; }
__device__ __forceinline__ float FMUL(float a, float b) { float r; asm("v_mul_f32 %0, %1, %2" : "=v"(r) : "v"(a), "v"(b)); return r; }
__device__ __forceinline__ float FFMA(float a, float b, float c) { float r; asm("v_fma_f32 %0, %1, %2, %3" : "=v"(r) : "v"(a), "v"(b), "v"(c)); return r; }
__device__ __forceinline__ float FFMS(float a, float b, float c) { float r; asm("v_fma_f32 %0, %1, %2, -%3" : "=v"(r) : "v"(a), "v"(b), "v"(c)); return r; }
__device__ __forceinline__ float FNMA(float a, float b, float c) { float r; asm("v_fma_f32 %0, -%1, %2, %3" : "=v"(r) : "v"(a), "v"(b), "v"(c)); return r; }
#endif
struct cpx { float x, y; };
FFT_HD cpx cmul(cpx a, cpx b) { cpx r; r.x = FFMS(a.x, b.x, FMUL(a.y, b.y)); r.y = FFMA(a.x, b.y, FMUL(a.y, b.x)); return r; }
FFT_HD cpx cmulc(cpx a, cpx b) { cpx r; r.x = FFMA(a.x, b.x, FMUL(a.y, b.y)); r.y = FFMS(a.y, b.x, FMUL(a.x, b.y)); return r; }
FFT_HD cpx cadd(cpx a, cpx b) { cpx r; r.x = FADD(a.x, b.x); r.y = FADD(a.y, b.y); return r; }
FFT_HD cpx csub(cpx a, cpx b) { cpx r; r.x = FSUB(a.x, b.x); r.y = FSUB(a.y, b.y); return r; }
FFT_HD cpx cconj(cpx a) { cpx r; r.x = a.x; r.y = -a.y; return r; }
FFT_HD cpx ldz(const FFT_LAS cpxv* Z, int i) { const cpxv v = Z[i]; cpx r; r.x = v.x; r.y = v.y; return r; }
FFT_HD void stz(FFT_LAS cpxv* Z, int i, cpx a) { cpxv v; v.x = a.x; v.y = a.y; Z[i] = v; }
template <bool INV> FFT_HD void bfly_rot(cpx a, cpx b, cpx& p, cpx& m) {
    if (!INV) { p.x = FADD(a.x, b.y); p.y = FSUB(a.y, b.x); m.x = FSUB(a.x, b.y); m.y = FADD(a.y, b.x); }
    else      { p.x = FSUB(a.x, b.y); p.y = FADD(a.y, b.x); m.x = FADD(a.x, b.y); m.y = FSUB(a.y, b.x); }
}
template <bool INV> FFT_HD void dft4(cpx& x0, cpx& x1, cpx& x2, cpx& x3) {
    const cpx a = cadd(x0, x2), b = csub(x0, x2), c = cadd(x1, x3), d = csub(x1, x3);
    x0 = cadd(a, c); x2 = csub(a, c); bfly_rot<INV>(b, d, x1, x3);
}
template <bool INV> FFT_HD cpx mul_w8(cpx a) { const float h = 0.70710678118654752440f; cpx r;
    if (!INV) { r.x = FMUL(h, FADD(a.x, a.y)); r.y = FMUL(h, FSUB(a.y, a.x)); } else { r.x = FMUL(h, FSUB(a.x, a.y)); r.y = FMUL(h, FADD(a.x, a.y)); } return r; }
template <bool INV> FFT_HD cpx mul_w8_3(cpx a) { const float h = 0.70710678118654752440f; cpx r;
    if (!INV) { r.x = FMUL(h, FSUB(a.y, a.x)); r.y = FMUL(-h, FADD(a.x, a.y)); } else { r.x = FMUL(-h, FADD(a.x, a.y)); r.y = FMUL(h, FSUB(a.x, a.y)); } return r; }
template <bool INV> FFT_HD cpx mul_mi(cpx a) { cpx r; if (!INV) { r.x = a.y; r.y = -a.x; } else { r.x = -a.y; r.y = a.x; } return r; }
template <bool INV> FFT_HD cpx twc(float c, float s) { cpx r; r.x = c; r.y = INV ? s : -s; return r; }
template <bool INV> FFT_HD void dft8(cpx (&x)[8]) {
    dft4<INV>(x[0], x[2], x[4], x[6]);
    dft4<INV>(x[1], x[3], x[5], x[7]);
    const cpx o1 = mul_w8<INV>(x[3]), o3 = mul_w8_3<INV>(x[7]);
    const cpx e0 = x[0], e1 = x[2], e2 = x[4], e3 = x[6], o0 = x[1], o2 = x[5];
    x[0] = cadd(e0, o0); x[4] = csub(e0, o0); x[1] = cadd(e1, o1); x[5] = csub(e1, o1);
    bfly_rot<INV>(e2, o2, x[2], x[6]);
    x[3] = cadd(e3, o3); x[7] = csub(e3, o3);
}
template <bool INV> FFT_HD void dft16(cpx (&x)[16]) {
    dft4<INV>(x[0], x[4], x[8], x[12]); dft4<INV>(x[1], x[5], x[9], x[13]); dft4<INV>(x[2], x[6], x[10], x[14]); dft4<INV>(x[3], x[7], x[11], x[15]);
    const float c1 = 0.92387953251128675613f, s1 = 0.38268343236508977173f;
    x[5] = cmul(x[5], twc<INV>(c1, s1));
    x[9] = mul_w8<INV>(x[9]);
    x[13] = cmul(x[13], twc<INV>(s1, c1));
    x[6] = mul_w8<INV>(x[6]);
    x[10] = mul_mi<INV>(x[10]);
    x[14] = mul_w8_3<INV>(x[14]);
    x[7] = cmul(x[7], twc<INV>(s1, c1));
    x[11] = mul_w8_3<INV>(x[11]);
    x[15] = cmul(x[15], twc<INV>(-c1, -s1));
    dft4<INV>(x[0], x[1], x[2], x[3]); dft4<INV>(x[4], x[5], x[6], x[7]); dft4<INV>(x[8], x[9], x[10], x[11]); dft4<INV>(x[12], x[13], x[14], x[15]);
    cpx t;
#define FFT_SW(a, b) t = x[a]; x[a] = x[b]; x[b] = t;
    FFT_SW(1, 4) FFT_SW(2, 8) FFT_SW(3, 12) FFT_SW(6, 9) FFT_SW(7, 13) FFT_SW(11, 14)
#undef FFT_SW
}
constexpr int FFT_P = 129;
FFT_HD int kmap(int p) { return (p >> 3) + 16 * (p & 7); }
FFT_HD int kinv(int k) { return 8 * (k & 15) + (k >> 4); }
constexpr int FFT_TW1 = 128 * FFT_P, FFT_TWS = FFT_TW1 + 2048, FFT_TWA = FFT_TWS + 128;
template <bool INV, int DIM> FFT_HD void pass16(FFT_LAS cpxv* Z, int tid, const cpx (&twA)[16]) {
#ifndef FFT_HOST
    asm volatile("" : "+v"(tid));
#endif
    const int i = tid >> 6;
#pragma unroll 1
    for (int h = 0; h < 2; ++h) {
        const int o = (tid & 63) + 64 * h;
        cpx x[16];
#pragma unroll
        for (int j = 0; j < 16; ++j) x[j] = ldz(Z, DIM == 0 ? (i + 8 * j) * FFT_P + o : o * FFT_P + i + 8 * j);
        if (INV) {
#pragma unroll
            for (int j = 1; j < 16; ++j) x[j] = cmulc(x[j], twA[j]);
        }
        dft16<INV>(x);
        if (!INV) {
#pragma unroll
            for (int j = 1; j < 16; ++j) x[j] = cmul(x[j], twA[j]);
        }
#pragma unroll
        for (int j = 0; j < 16; ++j) stz(Z, DIM == 0 ? (i + 8 * j) * FFT_P + o : o * FFT_P + i + 8 * j, x[j]);
    }
}
template <bool INV, int DIM> FFT_HD void pass8(FFT_LAS cpxv* Z, int tid) {
#ifndef FFT_HOST
    asm volatile("" : "+v"(tid));
#endif
#pragma unroll 1
    for (int q = 0; q < 4; ++q) {
        const int item = tid + 512 * q, o = item & 127, jp = item >> 7;
        cpx x[8];
#pragma unroll
        for (int m = 0; m < 8; ++m) x[m] = ldz(Z, DIM == 0 ? (8 * jp + m) * FFT_P + o : o * FFT_P + 8 * jp + m);
        if (DIM == 0) {
            const cpx w1 = ldz(Z, FFT_TW1 + item), ws = ldz(Z, FFT_TWS + o);
            if (INV) { cpx w = w1;
#pragma unroll
                for (int m = 0; m < 8; ++m) { x[m] = cmulc(x[m], w); if (m < 7) w = cmul(w, ws); } }
            dft8<INV>(x);
            if (!INV) { cpx w = w1;
#pragma unroll
                for (int m = 0; m < 8; ++m) { x[m] = cmul(x[m], w); if (m < 7) w = cmul(w, ws); } }
        } else dft8<INV>(x);
#pragma unroll
        for (int m = 0; m < 8; ++m) stz(Z, DIM == 0 ? (8 * jp + m) * FFT_P + o : o * FFT_P + 8 * jp + m, x[m]);
    }
}
FFT_HD int pos_of(int k) { return kinv(k & 127) * FFT_P + kinv(k >> 7); }
constexpr int LDS_RED = (128 * FFT_P + 2048 + 128 + 128) * 8;
static_assert(LDS_RED + 256 <= LDS_MISC, "LDS map");
__device__ __forceinline__ void fft_tables(LAS cpxv* Z, int tid, const cpxv* tw) {
    for (int e = tid; e < 2048; e += 512) Z[FFT_TW1 + e] = tw[((e >> 7) * (e & 127)) & 16383];
    if (tid < 128) { Z[FFT_TWS + tid] = tw[(16 * tid) & 16383]; Z[FFT_TWA + tid] = tw[128 * tid]; }
    __syncthreads();
}
__device__ __forceinline__ void load_twA(LAS cpxv* Z, int tid, cpx (&twA)[16]) { const int i = tid >> 6;
#pragma unroll
    for (int j = 0; j < 16; ++j) twA[j] = ldz(Z, FFT_TWA + ((i * j) & 127)); }
struct BgNone { __device__ __forceinline__ void load() {} __device__ __forceinline__ void put() {} };
struct BgScan {
    const unsigned* dS; unsigned* Sin; const float* dec; int q, dh, r2, kk, d; float s0, s1; unsigned x[4]; f32x2 dc[4];
    __device__ __forceinline__ void init(const Ctx& X, int e) { dS = (const unsigned*)(X.ws + R_DST); Sin = (unsigned*)(X.ws + R_SINT); dec = (const float*)(X.ws + R_DEC);
        dh = e / (DV * DK / 2); r2 = e % (DV * DK / 2); kk = (2 * r2) & (DK - 1); d = dh / NH; q = 0; s0 = 0.f; s1 = 0.f; }
    __device__ __forceinline__ int chunk(int qq) const { const int c = qq < NCH ? qq : NCH - 1; return d == 0 ? c : NCH - 1 - c; }
    __device__ __forceinline__ void load() {
#pragma unroll
        for (int j = 0; j < 4; ++j) { const int n = chunk(q + j); x[j] = dS[((size_t)dh * NCH + n) * (DV * DK / 2) + r2]; dc[j] = *(const f32x2*)(dec + ((size_t)dh * NCH + n) * DK + kk); }
    }
    __device__ __forceinline__ void put() {
        if (q < NCH) {
#pragma unroll
            for (int j = 0; j < 4; ++j) { const int n = chunk(q + j); Sin[((size_t)dh * NCH + n) * (DV * DK / 2) + r2] = pk2(s0, s1);
                s0 = s0 * dc[j][0] + bf2f(x[j] & 0xffffu); s1 = s1 * dc[j][1] + bf2f(x[j] >> 16); }
            q += 4;
        }
    }
    __device__ __forceinline__ void finish() { while (q < NCH) { load(); put(); } }
};
template <class BG> __device__ __forceinline__ void fft_fwd(LAS cpxv* Z, int tid, const cpxv* tw, BG& bg) {
    cpx twA[16]; load_twA(Z, tid, twA);
    bg.load(); pass16<false, 0>(Z, tid, twA); lds_barrier(); bg.put();
    bg.load(); pass8<false, 0>(Z, tid); lds_barrier(); bg.put();
    bg.load(); pass16<false, 1>(Z, tid, twA); lds_barrier(); bg.put();
    bg.load(); pass8<false, 1>(Z, tid); lds_barrier(); bg.put();
}

template <class BG> __device__ __forceinline__ void fft_inv(LAS cpxv* Z, int tid, const cpxv* tw, BG& bg) {
    cpx twA[16]; load_twA(Z, tid, twA);
    bg.load(); pass8<true, 1>(Z, tid); lds_barrier(); bg.put();
    bg.load(); pass16<true, 1>(Z, tid, twA); lds_barrier(); bg.put();
    bg.load(); pass8<true, 0>(Z, tid); lds_barrier(); bg.put();
    bg.load(); pass16<true, 0>(Z, tid, twA); lds_barrier(); bg.put();
}
__device__ __forceinline__ void spectra_task(const Ctx& X, int l, int o, int p, const bf16* k4T) {
    LAS cpxv* Z = (LAS cpxv*)X.lds; const cpxv* tw = (const cpxv*)(X.ws + WS_TW);
    const int tid = X.tid, t0 = 128 * (tid & 63) + 16 * (tid >> 6), c0 = 2 * p;
    float fa[16], fb[16], ba[16], bb[16];
    const float MIND = -3.0701134573253944f, MAXD = -15.350567286626972f;
    const float da = fabsf(MIND + (MAXD - MIND) * ((float)c0 / 1023.0f)), db = fabsf(MIND + (MAXD - MIND) * ((float)(c0 + 1) / 1023.0f));
    const bf16* r_fa = k4T + (size_t)(o * 2048 + c0) * L + t0; const bf16* r_ba = k4T + (size_t)(o * 2048 + 1024 + c0) * L + t0;
    float sa = 0.f, sb = 0.f;
#pragma unroll
    for (int q = 0; q < 4; ++q) { const v2u u0 = *(const v2u*)(r_fa + 4 * q), u1 = *(const v2u*)(r_fa + L + 4 * q), u2 = *(const v2u*)(r_ba + 4 * q), u3 = *(const v2u*)(r_ba + L + 4 * q);
        const f32x4 v0 = (f32x4){bf2f(u0.x & 0xffffu), bf2f(u0.x >> 16), bf2f(u0.y & 0xffffu), bf2f(u0.y >> 16)}, v1 = (f32x4){bf2f(u1.x & 0xffffu), bf2f(u1.x >> 16), bf2f(u1.y & 0xffffu), bf2f(u1.y >> 16)};
        const f32x4 v2 = (f32x4){bf2f(u2.x & 0xffffu), bf2f(u2.x >> 16), bf2f(u2.y & 0xffffu), bf2f(u2.y >> 16)}, v3 = (f32x4){bf2f(u3.x & 0xffffu), bf2f(u3.x >> 16), bf2f(u3.y & 0xffffu), bf2f(u3.y >> 16)};
#pragma unroll
        for (int j = 0; j < 4; ++j) { const int i = 4 * q + j; const float tn = (float)(t0 + i) * (1.0f / 8191.0f); const float wa = fexp(-tn * da), wb = fexp(-tn * db);
            fa[i] = v0[j] * wa; fb[i] = v1[j] * wb; ba[i] = v2[j] * wa; bb[i] = v3[j] * wb;
            sa += fabsf(fa[i]); sb += fabsf(fb[i]); if (t0 + i > 0) { sa += fabsf(ba[i]); sb += fabsf(bb[i]); } } }
    LAS float* red = (LAS float*)(X.lds + LDS_RED);
    sa = wave_sum(sa); sb = wave_sum(sb);
    if (X.lane == 0) { red[X.wave] = sa; red[8 + X.wave] = sb; }
    lds_barrier();
    float Sa = 0.f, Sb = 0.f;
#pragma unroll
    for (int w = 0; w < 8; ++w) { Sa += red[w]; Sb += red[8 + w]; }
    const float ia = 1.0f / Sa, ib = 1.0f / Sb;
#pragma unroll
    for (int i = 0; i < 16; ++i) { const int t = t0 + i; Z[(t >> 7) * FFT_P + (t & 127)] = (cpxv){fa[i] * ia, fb[i] * ib};
        const int n = t > 0 ? 2 * L - t : L;
        Z[(n >> 7) * FFT_P + (n & 127)] = (cpxv){t > 0 ? ba[i] * ia : 0.f, t > 0 ? bb[i] * ib : 0.f}; }
    lds_barrier();
    { BgNone bgn; fft_fwd(Z, tid, tw, bgn); }
    v2u* PM = (v2u*)(X.ws + WS_PM + (size_t)l * PM_LAYER) + (size_t)(o * 512 + p) * PMJ;
    const float sc = 0.5f / (float)NFFT;
#pragma unroll 1
    for (int q = 0; q < 17; ++q) { const int j = tid + 512 * q; if (j > 8192) break;
        const cpxv a = Z[pos_of(j)], b = Z[pos_of((NFFT - j) & (NFFT - 1))];
        const float kax = (a.x + b.x) * 0.5f, kay = (a.y - b.y) * 0.5f, kbx = (a.y + b.y) * 0.5f, kby = -(a.x - b.x) * 0.5f;
        PM[j] = (v2u){pk2((kax + kbx) * sc, (kay + kby) * sc), pk2((kax - kbx) * sc, (kay - kby) * sc)}; }
    lds_barrier();
}
struct Raw16 { v4u a, b; unsigned prev, next; };
__device__ __forceinline__ Raw16 load_raw16(const bf16* u, int t0) { Raw16 r; r.a = *(const v4u*)(u + t0); r.b = *(const v4u*)(u + t0 + 8); r.prev = t0 > 0 ? u[t0 - 1] : 0u; r.next = t0 + 16 < L ? u[t0 + 16] : 0u; return r; }
__device__ __forceinline__ void conv_raw16(const Raw16& r, float w0, float w1, float w2, float b, float (&o)[16]) {
    float v[18];
    v[0] = bf2f(r.prev); v[17] = bf2f(r.next);
    v[1] = bf2f(r.a.x & 0xffffu); v[2] = bf2f(r.a.x >> 16); v[3] = bf2f(r.a.y & 0xffffu); v[4] = bf2f(r.a.y >> 16); v[5] = bf2f(r.a.z & 0xffffu); v[6] = bf2f(r.a.z >> 16); v[7] = bf2f(r.a.w & 0xffffu); v[8] = bf2f(r.a.w >> 16);
    v[9] = bf2f(r.b.x & 0xffffu); v[10] = bf2f(r.b.x >> 16); v[11] = bf2f(r.b.y & 0xffffu); v[12] = bf2f(r.b.y >> 16); v[13] = bf2f(r.b.z & 0xffffu); v[14] = bf2f(r.b.z >> 16); v[15] = bf2f(r.b.w & 0xffffu); v[16] = bf2f(r.b.w >> 16);
#pragma unroll
    for (int i = 0; i < 16; ++i) o[i] = w0 * v[i] + w1 * v[i + 1] + w2 * v[i + 2] + b;
}
__device__ __forceinline__ void load_conv16(const bf16* u, int t0, float w0, float w1, float w2, float b, float (&o)[16]) {
    const v4u x0 = *(const v4u*)(u + t0), x1 = *(const v4u*)(u + t0 + 8);
    float v[18];
    v[0] = t0 > 0 ? bf2f(u[t0 - 1]) : 0.f; v[17] = t0 + 16 < L ? bf2f(u[t0 + 16]) : 0.f;
    v[1] = bf2f(x0.x & 0xffffu); v[2] = bf2f(x0.x >> 16); v[3] = bf2f(x0.y & 0xffffu); v[4] = bf2f(x0.y >> 16); v[5] = bf2f(x0.z & 0xffffu); v[6] = bf2f(x0.z >> 16); v[7] = bf2f(x0.w & 0xffffu); v[8] = bf2f(x0.w >> 16);
    v[9] = bf2f(x1.x & 0xffffu); v[10] = bf2f(x1.x >> 16); v[11] = bf2f(x1.y & 0xffffu); v[12] = bf2f(x1.y >> 16); v[13] = bf2f(x1.z & 0xffffu); v[14] = bf2f(x1.z >> 16); v[15] = bf2f(x1.w & 0xffffu); v[16] = bf2f(x1.w >> 16);
#pragma unroll
    for (int i = 0; i < 16; ++i) o[i] = w0 * v[i] + w1 * v[i + 1] + w2 * v[i + 2] + b;
}
__device__ __forceinline__ int hy_jmap(int tid, int q) { return kmap(tid & 127) + 128 * (4 * q + (tid >> 7)); }
__device__ __forceinline__ void hy_pair(LAS cpxv* Z, int j, v2u pm) {
    const int p = pos_of(j), pp = pos_of((NFFT - j) & (NFFT - 1)); cpx P, M; P.x = bf2f(pm.x & 0xffffu); P.y = bf2f(pm.x >> 16); M.x = bf2f(pm.y & 0xffffu); M.y = bf2f(pm.y >> 16);
    const cpx zp = ldz(Z, p), zq = ldz(Z, pp);
    const cpx y1 = cadd(cmul(zp, P), cmul(cconj(zq), M)), y2 = cadd(cmulc(zq, P), cconj(cmul(zp, M)));
    stz(Z, p, y1); if (pp != p) stz(Z, pp, y2);
}
__device__ __forceinline__ void hy_pointwise(LAS cpxv* Z, const v2u* PM, const v2u (&pm)[16], int tid) {
    asm volatile("" : "+v"(tid));
#pragma unroll
    for (int q = 0; q < 16; ++q) { hy_pair(Z, hy_jmap(tid, q), pm[q]); if ((q & 3) == 3) __builtin_amdgcn_sched_barrier(0); }
    if (tid == 0) hy_pair(Z, 8192, PM[8192]);
    lds_barrier();
}
__device__ __forceinline__ void hy_fill(LAS cpxv* Z, int tid, const float (&za)[16], const float (&zb)[16]) {
    asm volatile("" : "+v"(tid));
    const int t0 = 128 * (tid & 63) + 16 * (tid >> 6);
#pragma unroll
    for (int i = 0; i < 16; ++i) { const int t = t0 + i; Z[(t >> 7) * FFT_P + (t & 127)] = (cpxv){za[i], zb[i]}; }
#pragma unroll
    for (int q = 0; q < 16; ++q) { const int e = tid + 512 * q; Z[(64 + (e >> 7)) * FFT_P + (e & 127)] = (cpxv){0.f, 0.f}; }
    lds_barrier();
}
template <class BG> __device__ __forceinline__ void hyena_task(const Ctx& X, int l, int p, BG& bg) {
    LAS cpxv* Z = (LAS cpxv*)X.lds; const cpxv* tw = (const cpxv*)(X.ws + WS_TW);
    const int tid = X.tid, t0 = 128 * (tid & 63) + 16 * (tid >> 6), c0 = 2 * p, c1 = c0 + 1;
    const bf16* uT = (const bf16*)(X.ws + R_UT); const float* cw = X.in(I_CONV_W) + (size_t)l * 3 * 3072; const float* cb = X.in(I_CONV_B) + (size_t)l * 3072; const float* skip = X.in(I_SKIP) + (size_t)l * 2 * 1024;
    float za[16], zb[16];
    load_conv16(uT + (size_t)c0 * L, t0, cw[c0], cw[3072 + c0], cw[2 * 3072 + c0], cb[c0], za);
    load_conv16(uT + (size_t)c1 * L, t0, cw[c1], cw[3072 + c1], cw[2 * 3072 + c1], cb[c1], zb);
#pragma unroll 1
    for (int o = 0; o < 2; ++o) {
        const v2u* PM = (const v2u*)(X.ws + WS_PM + (size_t)l * PM_LAYER) + (size_t)(o * 512 + p) * PMJ; v2u pm[16];
        const int ch0 = (o + 1) * 1024 + c0, ch1 = ch0 + 1;
        const Raw16 ra = load_raw16(uT + (size_t)ch0 * L, t0), rb = load_raw16(uT + (size_t)ch1 * L, t0);
        { int tq = tid; asm volatile("" : "+v"(tq));
#pragma unroll
          for (int q = 0; q < 16; ++q) pm[q] = PM[hy_jmap(tq, q)]; }
        hy_fill(Z, tid, za, zb);
#if defined(PROBE_FILL)
        for (int rr = 0; rr < PROBE_FILL; ++rr) hy_fill(Z, tid, za, zb);
#endif
#if defined(PROBE_FFT) && PROBE_FFT
        for (int rr = 0; rr < PROBE_FFT; ++rr) { BgNone bgn; fft_fwd(Z, tid, tw, bgn); fft_inv(Z, tid, tw, bgn);
            for (int e = tid; e < 128 * 128; e += 512) { const int ix = (e >> 7) * FFT_P + (e & 127); cpxv v = Z[ix]; v.x *= (1.0f / NFFT); v.y *= (1.0f / NFFT); Z[ix] = v; }
            __syncthreads(); }
#endif
        fft_fwd(Z, tid, tw, bg);
        hy_pointwise(Z, PM, pm, tid);
        fft_inv(Z, tid, tw, bg);
        float xa[16], xb_[16];
        conv_raw16(ra, cw[ch0], cw[3072 + ch0], cw[2 * 3072 + ch0], cb[ch0], xa);
        conv_raw16(rb, cw[ch1], cw[3072 + ch1], cw[2 * 3072 + ch1], cb[ch1], xb_);
        const float ska = skip[o * 1024 + c0], skb = skip[o * 1024 + c1];
        int t0r = t0; asm volatile("" : "+v"(t0r));
#pragma unroll
        for (int i = 0; i < 16; ++i) { const int t = t0r + i; const cpxv y = Z[(t >> 7) * FFT_P + (t & 127)];
            za[i] = xa[i] * (y.x + za[i] * ska); zb[i] = xb_[i] * (y.y + zb[i] * skb); }
        lds_barrier();
    }
    bf16* hyT = (bf16*)(X.ws + R_HYT);
    v4u w0, w1;
    w0.x = pk2(za[0], za[1]); w0.y = pk2(za[2], za[3]); w0.z = pk2(za[4], za[5]); w0.w = pk2(za[6], za[7]); w1.x = pk2(za[8], za[9]); w1.y = pk2(za[10], za[11]); w1.z = pk2(za[12], za[13]); w1.w = pk2(za[14], za[15]);
    *(v4u*)(hyT + (size_t)c0 * L + t0) = w0; *(v4u*)(hyT + (size_t)c0 * L + t0 + 8) = w1;
    w0.x = pk2(zb[0], zb[1]); w0.y = pk2(zb[2], zb[3]); w0.z = pk2(zb[4], zb[5]); w0.w = pk2(zb[6], zb[7]); w1.x = pk2(zb[8], zb[9]); w1.y = pk2(zb[10], zb[11]); w1.z = pk2(zb[12], zb[13]); w1.w = pk2(zb[14], zb[15]);
    *(v4u*)(hyT + (size_t)c1 * L + t0) = w0; *(v4u*)(hyT + (size_t)c1 * L + t0 + 8) = w1;
}
__device__ __forceinline__ f32x4 mma16_lds(const LAS bf16* A, int lda, const LAS bf16* Bt, int ldb, int K, int lane, f32x4 acc) {
    const LAS bf16* ap = A + (lane & 15) * lda + 8 * (lane >> 4); const LAS bf16* bp = Bt + (lane & 15) * ldb + 8 * (lane >> 4);
    for (int kb = 0; kb < K; kb += 32) { const bf16x8 a = *(const LAS bf16x8*)(ap + kb), b = *(const LAS bf16x8*)(bp + kb); acc = __builtin_amdgcn_mfma_f32_16x16x32_bf16(a, b, acc, 0, 0, 0); }
    return acc;
}
__device__ __forceinline__ void lr_phase(const Ctx& X, int l, const u64* sumsq) {
    const bf16* xb = (const bf16*)(X.ws + WS_XB); const bf16* W = (const bf16*)(X.ws + WS_W + l * W_LAYER + W_LR); float* lr = (float*)(X.ws + WS_LR);
    LAS float* red = (LAS float*)X.lds;
    const int lane = X.lane, w = X.wave;
    for (int u = X.bid; u < L / 32; u += X.G) {
        const int r0 = 32 * u; f32x4 acc[2][2] = {{{0.f, 0.f, 0.f, 0.f}, {0.f, 0.f, 0.f, 0.f}}, {{0.f, 0.f, 0.f, 0.f}, {0.f, 0.f, 0.f, 0.f}}};
#pragma unroll
        for (int ks = 0; ks < 8; ++ks) { const int k = 256 * w + 32 * ks + 8 * (lane >> 4); bf16x8 a[2], b[2];
#pragma unroll
            for (int i = 0; i < 2; ++i) { a[i] = *(const bf16x8*)(xb + (size_t)(r0 + 16 * i + (lane & 15)) * D + k); b[i] = *(const bf16x8*)(W + (size_t)(16 * i + (lane & 15)) * D + k); }
#pragma unroll
            for (int i = 0; i < 2; ++i)
#pragma unroll
                for (int j = 0; j < 2; ++j) acc[i][j] = __builtin_amdgcn_mfma_f32_16x16x32_bf16(a[i], b[j], acc[i][j], 0, 0, 0); }
#pragma unroll
        for (int i = 0; i < 2; ++i)
#pragma unroll
            for (int j = 0; j < 2; ++j) *(LAS f32x4*)(red + ((w * 4 + i * 2 + j) * 64 + lane) * 4) = acc[i][j];
        lds_barrier();
        if (X.tid < 256) { const int tile = X.tid >> 6, ln = X.tid & 63; f32x4 s = (f32x4){0.f, 0.f, 0.f, 0.f};
#pragma unroll
            for (int ww = 0; ww < 8; ++ww) s += *(LAS f32x4*)(red + ((ww * 4 + tile) * 64 + ln) * 4);
            const int i = tile >> 1, j = tile & 1, col = 16 * j + (ln & 15);
#pragma unroll
            for (int rg = 0; rg < 4; ++rg) { const int row = r0 + 16 * i + 4 * (ln >> 4) + rg; lr[(size_t)row * 32 + col] = s[rg] * rstd_of(sumsq, row); } }
        lds_barrier();
    }
}
constexpr int G1_QT = 0, G1_KT = 17408, G1_KOT = 0, G1_SC = 18432, G1_V = 34816, G1_VT = 68608, G1_QI = 105472, G1_KI = 122880, G1_LRS = 140288, G1_TOT = 148480;
static_assert(G1_TOT + 4096 <= LDS_MISC, "G1 LDS map");
template <int DIR> __device__ __forceinline__ void g1_dir(const Ctx& X, int h, int n, int kk, int rg, const float (&cum)[16], float off, float tot, const float (&qv)[16], const float (&kv)[16], f32x4 (&oacc)[2][4]) {
    LAS bf16* QI = (LAS bf16*)(X.lds + G1_QI); LAS bf16* KI = (LAS bf16*)(X.lds + G1_KI); LAS bf16* KOT = (LAS bf16*)(X.lds + G1_KOT); LAS bf16* VT = (LAS bf16*)(X.lds + G1_VT); LAS bf16* SC = (LAS bf16*)(X.lds + G1_SC);
    const int lane = X.lane, w = X.wave, t0 = 64 * n;
    unsigned ko[8];
#pragma unroll
    for (int i = 0; i < 16; ++i) { const int row = 16 * rg + i; const float b = off + cum[i];
        const float qi = qv[i] * 0.08838834764831845f * fexp(b), ki = kv[i] * fexp(-b), kov = kv[i] * fexp(tot - b);
        QI[row * 136 + kk] = (bf16)f2bf(qi); KI[row * 136 + kk] = (bf16)f2bf(ki);
        if (i & 1) ko[i >> 1] |= f2bf(kov) << 16; else ko[i >> 1] = f2bf(kov); }
    *(LAS v4u*)(KOT + kk * 72 + 16 * rg) = (v4u){ko[0], ko[1], ko[2], ko[3]}; *(LAS v4u*)(KOT + kk * 72 + 16 * rg + 8) = (v4u){ko[4], ko[5], ko[6], ko[7]};
    if (rg == 0) ((float*)(X.ws + R_DEC))[((size_t)(DIR * NH + h) * NCH + n) * DK + kk] = fexp(tot);
    lds_barrier();
    { bf16* qig = (bf16*)(X.ws + R_QI) + ((size_t)DIR * L + t0) * DKT + h * DK;
#pragma unroll
      for (int i = 0; i < 2; ++i) { const int id = X.tid + 512 * i, row = id >> 4, c16 = id & 15; *(v4u*)(qig + (size_t)row * DKT + 8 * c16) = *(const LAS v4u*)(QI + row * 136 + 8 * c16); } }
#pragma unroll
    for (int tt = 0; tt < 2; ++tt) { const int tile = 2 * w + tt, mj = tile >> 2, ni = tile & 3;
        f32x4 s = mma16_lds(KI + 16 * mj * 136, 136, QI + 16 * ni * 136, 136, 128, lane, (f32x4){0.f, 0.f, 0.f, 0.f});
        const int i = 16 * ni + (lane & 15), j0 = 16 * mj + 4 * (lane >> 4);
#pragma unroll
        for (int r = 0; r < 4; ++r) { const bool keep = DIR == 0 ? (j0 + r <= i) : (j0 + r > i); if (!keep) s[r] = 0.f; }
        *(LAS v2u*)(SC + i * 72 + j0) = (v2u){pk2(s[0], s[1]), pk2(s[2], s[3])}; }
    lds_barrier();
#pragma unroll
    for (int a = 0; a < 2; ++a)
#pragma unroll
        for (int b = 0; b < 4; ++b) oacc[a][b] = mma16_lds(VT + 16 * (2 * w + a) * 72, 72, SC + 16 * b * 72, 72, 64, lane, oacc[a][b]);
    bf16* dst = (bf16*)(X.ws + R_DST) + ((size_t)(DIR * NH + h) * NCH + n) * (DV * DK);
#pragma unroll 1
    for (int mk = 0; mk < 8; ++mk)
#pragma unroll
        for (int a = 0; a < 2; ++a) { const int nv = 2 * w + a;
            const f32x4 s = mma16_lds(KOT + 16 * mk * 72, 72, VT + 16 * nv * 72, 72, 64, lane, (f32x4){0.f, 0.f, 0.f, 0.f});
            *(v2u*)(dst + (size_t)(16 * nv + (lane & 15)) * DK + 16 * mk + 4 * (lane >> 4)) = (v2u){pk2(s[0], s[1]), pk2(s[2], s[3])}; }
    lds_barrier();
}
__device__ __forceinline__ void gla_g1(const Ctx& X, int l, int h, int n) {
    const int tid = X.tid, kk = tid & 127, rg = tid >> 7, t0 = 64 * n;
    const bf16* qkvr = (const bf16*)(X.ws + R_QKVR);
    LAS float* LRS = (LAS float*)(X.lds + G1_LRS); LAS float* TOT = (LAS float*)(X.lds + G1_TOT); LAS bf16* VT = (LAS bf16*)(X.lds + G1_VT);
    LAS bf16* QT = (LAS bf16*)(X.lds + G1_QT); LAS bf16* KT = (LAS bf16*)(X.lds + G1_KT); LAS bf16* VR = (LAS bf16*)(X.lds + G1_V);
    {
      v4u qc[2], kc[2], vc4[4];
#pragma unroll
      for (int i = 0; i < 2; ++i) { const int id = tid + 512 * i, row = id >> 4, c16 = id & 15; const bf16* rp = qkvr + (size_t)(t0 + row) * 3072 + h * DK + 8 * c16; qc[i] = *(const v4u*)rp; kc[i] = *(const v4u*)(rp + 512); }
#pragma unroll
      for (int i = 0; i < 4; ++i) { const int id = tid + 512 * i, row = id >> 5, c16 = id & 31; vc4[i] = *(const v4u*)(qkvr + (size_t)(t0 + row) * 3072 + 1024 + h * DV + 8 * c16); }
      const f32x4 lrv = *(const f32x4*)((const float*)(X.ws + WS_LR) + (size_t)t0 * 32 + 4 * tid);
#pragma unroll
      for (int i = 0; i < 2; ++i) { const int id = tid + 512 * i, row = id >> 4, c16 = id & 15; *(LAS v4u*)(QT + row * 136 + 8 * c16) = qc[i]; *(LAS v4u*)(KT + row * 136 + 8 * c16) = kc[i]; }
#pragma unroll
      for (int i = 0; i < 4; ++i) { const int id = tid + 512 * i, row = id >> 5, c16 = id & 31; *(LAS v4u*)(VR + row * 264 + 8 * c16) = vc4[i]; }
      *(LAS f32x4*)(LRS + 4 * tid) = lrv; }
    lds_barrier();
    {
      const int vc = tid & 255, tg = tid >> 8; unsigned pk[16];
#pragma unroll
      for (int i = 0; i < 32; ++i) { const unsigned x = VR[(32 * tg + i) * 264 + vc]; if (i & 1) pk[i >> 1] |= x << 16; else pk[i >> 1] = x; }
#pragma unroll
      for (int q = 0; q < 4; ++q) *(LAS v4u*)(VT + vc * 72 + 32 * tg + 8 * q) = (v4u){pk[4 * q], pk[4 * q + 1], pk[4 * q + 2], pk[4 * q + 3]}; }
    float qv[16], kv[16];
#pragma unroll
    for (int i = 0; i < 16; ++i) { qv[i] = bf2f(QT[(16 * rg + i) * 136 + kk]); kv[i] = bf2f(KT[(16 * rg + i) * 136 + kk]); }
    const float* w2 = X.in(I_GW2) + (size_t)l * 2 * LRK * DKT + h * DK + kk; const float* gb = X.in(I_GB) + (size_t)l * 2 * DKT + h * DK + kk;
    float wf[16], wb[16];
#pragma unroll
    for (int r = 0; r < 16; ++r) { wf[r] = w2[(size_t)r * DKT]; wb[r] = w2[(size_t)(LRK + r) * DKT]; }
    const float bf_ = gb[0], bb_ = gb[DKT];
    lds_barrier();
    float cf[16], cb[16];
#pragma unroll
    for (int i = 0; i < 16; ++i) { const LAS float* lrow = LRS + (16 * rg + i) * 32; float xf = bf_, xb2 = bb_;
#pragma unroll
        for (int r = 0; r < 16; ++r) { xf += lrow[r] * wf[r]; xb2 += lrow[16 + r] * wb[r]; }
        cf[i] = flogsigmoid(xf) * (1.0f / 16.0f); cb[i] = flogsigmoid(xb2) * (1.0f / 16.0f); }
#pragma unroll
    for (int i = 1; i < 16; ++i) cf[i] += cf[i - 1];
#pragma unroll
    for (int i = 14; i >= 0; --i) cb[i] += cb[i + 1];
    TOT[(0 * 4 + rg) * 128 + kk] = cf[15]; TOT[(1 * 4 + rg) * 128 + kk] = cb[0];
    lds_barrier();
    float offf = 0.f, totf = 0.f, offb = 0.f, totb = 0.f;
#pragma unroll
    for (int g = 0; g < 4; ++g) { const float a = TOT[(0 * 4 + g) * 128 + kk], b = TOT[(1 * 4 + g) * 128 + kk]; totf += a; totb += b; if (g < rg) offf += a; if (g > rg) offb += b; }
    f32x4 oacc[2][4];
#pragma unroll
    for (int a = 0; a < 2; ++a)
#pragma unroll
        for (int b = 0; b < 4; ++b) oacc[a][b] = (f32x4){0.f, 0.f, 0.f, 0.f};
    g1_dir<0>(X, h, n, kk, rg, cf, offf, totf, qv, kv, oacc);
    g1_dir<1>(X, h, n, kk, rg, cb, offb, totb, qv, kv, oacc);
    bf16* oi = (bf16*)(X.ws + R_OINTRA);
#pragma unroll
    for (int a = 0; a < 2; ++a)
#pragma unroll
        for (int b = 0; b < 4; ++b) *(v2u*)(oi + (size_t)(t0 + 16 * b + (X.lane & 15)) * DVT + h * DV + 16 * (2 * X.wave + a) + 4 * (X.lane >> 4)) = (v2u){pk2(oacc[a][b][0], oacc[a][b][1]), pk2(oacc[a][b][2], oacc[a][b][3])};
}
__device__ __forceinline__ void gla_g2(const Ctx& X, int first) {
    const unsigned* dS = (const unsigned*)(X.ws + R_DST); unsigned* Sin = (unsigned*)(X.ws + R_SINT); const float* dec = (const float*)(X.ws + R_DEC);
    for (int e = first; e < 2 * NH * DV * DK / 2; e += X.G * 512) {
        const int dh = e / (DV * DK / 2), r2 = e % (DV * DK / 2), kk = (2 * r2) & (DK - 1), d = dh / NH;
        float s0 = 0.f, s1 = 0.f;
#pragma unroll 8
        for (int q = 0; q < NCH; ++q) { const int n = d == 0 ? q : NCH - 1 - q; const size_t idx = ((size_t)dh * NCH + n) * (DV * DK / 2) + r2;
            const unsigned x = dS[idx]; const f32x2 dc = *(const f32x2*)(dec + ((size_t)dh * NCH + n) * DK + kk);
            Sin[idx] = pk2(s0, s1);
            s0 = s0 * dc[0] + bf2f(x & 0xffffu); s1 = s1 * dc[1] + bf2f(x >> 16); }
    }
}
constexpr int G3_QIL = 0, G3_RED = 36864;
__device__ __forceinline__ void gla_g3(const Ctx& X, int l, int h, int n) {
    const int lane = X.lane, w = X.wave, tid = X.tid, t0 = 64 * n;
    const bf16* SinT = (const bf16*)(X.ws + R_SINT); const bf16* qig = (const bf16*)(X.ws + R_QI); const bf16* oi = (const bf16*)(X.ws + R_OINTRA);
    const bf16* qkvr = (const bf16*)(X.ws + R_QKVR); bf16* gla = (bf16*)(X.ws + R_GLA); const float* ng = X.in(I_GNORM) + l * DV;
    LAS bf16* QIL = (LAS bf16*)(X.lds + G3_QIL);
    LAS float* RED = (LAS float*)(X.lds + G3_RED);
    v4u qc[4];
#pragma unroll
    for (int i = 0; i < 4; ++i) { const int id = tid + 512 * i, d = id >> 10, r = (id >> 4) & 63, c = id & 15; qc[i] = *(const v4u*)(qig + ((size_t)d * L + t0 + r) * DKT + h * DK + 8 * c); }
    bf16x8 av[2][2][4];
#pragma unroll
    for (int d = 0; d < 2; ++d) { const bf16* S = SinT + ((size_t)(d * NH + h) * NCH + n) * (DV * DK);
#pragma unroll
        for (int a = 0; a < 2; ++a)
#pragma unroll
            for (int ks = 0; ks < 4; ++ks) av[d][a][ks] = *(const bf16x8*)(S + (size_t)(16 * (2 * w + a) + (lane & 15)) * DK + 32 * ks + 8 * (lane >> 4)); }
    f32x4 ov[2][4]; v2u sr[2][4];
#pragma unroll
    for (int b = 0; b < 4; ++b)
#pragma unroll
        for (int a = 0; a < 2; ++a) { const size_t o = (size_t)(t0 + 16 * b + (lane & 15)) * DVT + h * DV + 16 * (2 * w + a) + 4 * (lane >> 4); { const v2u t_ = *(const v2u*)(oi + o); ov[a][b] = (f32x4){bf2f(t_.x & 0xffffu), bf2f(t_.x >> 16), bf2f(t_.y & 0xffffu), bf2f(t_.y >> 16)}; }
            sr[a][b] = *(const v2u*)(qkvr + (size_t)(t0 + 16 * b + (lane & 15)) * 3072 + 2048 + h * DV + 16 * (2 * w + a) + 4 * (lane >> 4)); }
#pragma unroll
    for (int i = 0; i < 4; ++i) { const int id = tid + 512 * i, d = id >> 10, r = (id >> 4) & 63, c = id & 15; *(LAS v4u*)(QIL + (d * 64 + r) * 136 + 8 * c) = qc[i]; }
    lds_barrier();
    f32x4 acc[2][4];
#pragma unroll
    for (int a = 0; a < 2; ++a)
#pragma unroll
        for (int b = 0; b < 4; ++b) acc[a][b] = (f32x4){0.f, 0.f, 0.f, 0.f};
#pragma unroll
    for (int d = 0; d < 2; ++d)
#pragma unroll
        for (int ks = 0; ks < 4; ++ks) { bf16x8 bv[4];
#pragma unroll
            for (int b = 0; b < 4; ++b) bv[b] = *(const LAS bf16x8*)(QIL + (d * 64 + 16 * b + (lane & 15)) * 136 + 32 * ks + 8 * (lane >> 4));
#pragma unroll
            for (int a = 0; a < 2; ++a)
#pragma unroll
                for (int b = 0; b < 4; ++b) acc[a][b] = __builtin_amdgcn_mfma_f32_16x16x32_bf16(av[d][a][ks], bv[b], acc[a][b], 0, 0, 0); }
    float ss[4];
#pragma unroll
    for (int b = 0; b < 4; ++b) { ss[b] = 0.f;
#pragma unroll
        for (int a = 0; a < 2; ++a) { acc[a][b] += ov[a][b];
            ss[b] += (acc[a][b][0] * acc[a][b][0] + acc[a][b][1] * acc[a][b][1]) + (acc[a][b][2] * acc[a][b][2] + acc[a][b][3] * acc[a][b][3]); }
        ss[b] += __shfl_xor(ss[b], 16); ss[b] += __shfl_xor(ss[b], 32);
        if (lane < 16) RED[w * 64 + 16 * b + lane] = ss[b]; }
    lds_barrier();
#pragma unroll
    for (int b = 0; b < 4; ++b) { const int tl = 16 * b + (lane & 15); float tot = 0.f;
#pragma unroll
        for (int ww = 0; ww < 8; ++ww) tot += RED[ww * 64 + tl];
        const float rs = __builtin_amdgcn_rsqf(tot * (1.0f / DV) + RMS_EPS);
#pragma unroll
        for (int a = 0; a < 2; ++a) { const int v0 = 16 * (2 * w + a) + 4 * (lane >> 4); const f32x4 g4 = *(const f32x4*)(ng + v0);
            const f32x4 o = acc[a][b] * rs * g4; const v2u s2 = sr[a][b];
            *(v2u*)(gla + (size_t)(t0 + tl) * DVT + h * DV + v0) = (v2u){pk2(o[0] * bf2f(s2.x & 0xffffu), o[1] * bf2f(s2.x >> 16)), pk2(o[2] * bf2f(s2.y & 0xffffu), o[3] * bf2f(s2.y >> 16))}; } }
    lds_barrier();
}
__device__ __forceinline__ void hy_transpose(const Ctx& X) {
    const bf16* hyT = (const bf16*)(X.ws + R_HYT); bf16* hy = (bf16*)(X.ws + R_HY);
    LAS bf16* scr = (LAS bf16*)(X.lds + 40960 + X.wave * 9216);
    const int lane = X.lane, r = lane >> 3, ch = lane & 7;
    for (int it = X.bid * 8 + X.wave; it < 16 * 128; it += X.G * 8) { const int c0 = 64 * (it >> 7), t0 = 64 * (it & 127);
        v4u v[8];
#pragma unroll
        for (int i = 0; i < 8; ++i) v[i] = *(const v4u*)(hyT + (size_t)(c0 + 8 * i + r) * L + t0 + 8 * ch);
#pragma unroll
        for (int i = 0; i < 8; ++i) *(LAS v4u*)(scr + (8 * i + r) * 72 + 8 * ch) = v[i];
        LDS_WAIT(); asm volatile("" ::: "memory");
#pragma unroll
        for (int i = 0; i < 8; ++i) { const int t = 8 * i + r; const LAS bf16* sp = scr + (8 * ch) * 72 + t;
            v4u o; o.x = (unsigned)sp[0] | ((unsigned)sp[72] << 16); o.y = (unsigned)sp[2 * 72] | ((unsigned)sp[3 * 72] << 16); o.z = (unsigned)sp[4 * 72] | ((unsigned)sp[5 * 72] << 16); o.w = (unsigned)sp[6 * 72] | ((unsigned)sp[7 * 72] << 16);
            *(v4u*)(hy + (size_t)(t0 + t) * HW + c0 + 8 * ch) = o; }
        LDS_WAIT(); asm volatile("" ::: "memory"); }
}
constexpr size_t WS_ROWSCALE = WS_TW + 256 * 1024, WS_ROWGATE = WS_TW + 512 * 1024;
__device__ __forceinline__ void router_phase(const Ctx& X, const u64* sumsq) {
    LAS float* WR = (LAS float*)X.lds;
    { const float* rw = X.in(I_ROUTER); const float* nf = X.in(I_NORM_FFN) + D;
      for (int i = X.tid; i < NE * D; i += 512) { const int e = i / D, k = i % D; WR[i] = rw[(size_t)k * NE + e] * nf[k]; } }
    __syncthreads();
    const float* xres = (const float*)(X.ws + WS_XRES); int* tok = (int*)(X.ctl + CW_TOK); unsigned* cnt = X.ctl + CW_CNT;
    for (int t = X.bid * 8 + X.wave; t < L; t += X.G * 8) {
        const f32x4* xr = (const f32x4*)(xres + (size_t)t * D) + X.lane; float lg[NE];
#pragma unroll
        for (int e = 0; e < NE; ++e) lg[e] = 0.f;
#pragma unroll 1
        for (int j = 0; j < 8; ++j) { const f32x4 v = xr[64 * j];
#pragma unroll
            for (int e = 0; e < NE; ++e) { const f32x4 wv = *(const LAS f32x4*)(WR + e * D + 4 * X.lane + 256 * j); lg[e] += (v[0] * wv[0] + v[1] * wv[1]) + (v[2] * wv[2] + v[3] * wv[3]); } }
        const float rs = rstd_of(sumsq, t);
#pragma unroll
        for (int e = 0; e < NE; ++e) lg[e] = wave_sum(lg[e]) * rs;
        int i1 = 0; float l1 = lg[0];
#pragma unroll
        for (int e = 1; e < NE; ++e) if (lg[e] > l1) { l1 = lg[e]; i1 = e; }
        int i2 = -1; float l2 = -3.0e38f;
#pragma unroll
        for (int e = 0; e < NE; ++e) if (e != i1 && lg[e] > l2) { l2 = lg[e]; i2 = e; }
        const float g1 = __builtin_amdgcn_rcpf(1.0f + fexp(l2 - l1)), g2 = 1.0f - g1;
        if (X.lane == 0) { const unsigned s1 = atomicAdd(cnt + i1, 1u), s2 = atomicAdd(cnt + i2, 1u);
            tok[t * 8 + 0] = i1; tok[t * 8 + 1] = (int)s1; tok[t * 8 + 2] = (int)__builtin_bit_cast(unsigned, g1); tok[t * 8 + 3] = i2; tok[t * 8 + 4] = (int)s2; tok[t * 8 + 5] = (int)__builtin_bit_cast(unsigned, g2); }
    }
}
__device__ __forceinline__ void moe_tables(const Ctx& X) {
    if (X.tid == 0) { unsigned tb = 0; for (int e = 0; e < NE; ++e) { const unsigned c = __hip_atomic_load(X.ctl + CW_CNT + e, RLX_AGENT), nt = (c + 255u) >> 8; X.misc[16 + e] = nt; X.misc[24 + e] = tb; tb += nt; }
        const unsigned U = 8u * tb, G = (unsigned)X.G; unsigned nnorm = (U / G) * G, urem = U - nnorm, S = 1u;
        if (urem > 0u && urem <= G / 4u) S = 4u; else if (urem > 0u && urem <= G / 2u) S = 2u;
        if (S == 1u) { nnorm = U; urem = 0u; }
        X.misc[32] = nnorm; X.misc[33] = S; X.misc[34] = urem; }
    __syncthreads();
}
__device__ __forceinline__ void gather_phase(const Ctx& X, const u64* sumsq) {
    moe_tables(X);
    const float* xres = (const float*)(X.ws + WS_XRES); unsigned char* xg = (unsigned char*)(X.ws + R_XG); int* tok = (int*)(X.ctl + CW_TOK);
    float* rowscale = (float*)(X.ws + WS_ROWSCALE); float* rowgate = (float*)(X.ws + WS_ROWGATE);
    f32x4 g[8];
#pragma unroll
    for (int j = 0; j < 8; ++j) g[j] = *((const f32x4*)(X.in(I_NORM_FFN) + D) + X.lane + 64 * j);
    for (int t = X.bid * 8 + X.wave; t < L; t += X.G * 8) {
        const f32x4* src = (const f32x4*)(xres + (size_t)t * D) + X.lane; unsigned v[8];
        const float rs = rstd_of(sumsq, t) * F8_ASCALE;
#pragma unroll
        for (int j = 0; j < 8; ++j) { f32x4 a = src[64 * j] * g[j] * rs;
#pragma unroll
            for (int q = 0; q < 4; ++q) a[q] = fminf(fmaxf(a[q], -448.0f), 448.0f);
            int w = 0; w = __builtin_amdgcn_cvt_pk_fp8_f32(a[0], a[1], w, false); w = __builtin_amdgcn_cvt_pk_fp8_f32(a[2], a[3], w, true); v[j] = (unsigned)w; }
#pragma unroll
        for (int s = 0; s < 2; ++s) { const int e = tok[t * 8 + 3 * s], slot = tok[t * 8 + 3 * s + 1]; const int row = 256 * (int)X.misc[24 + e] + slot;
            unsigned* dst = (unsigned*)(xg + (size_t)row * D) + X.lane;
#pragma unroll
            for (int j = 0; j < 8; ++j) dst[64 * j] = v[j];
            if (X.lane == 0) { rowscale[row] = 1.0f / (F8_WSCALE * F8_ASCALE); rowgate[row] = __builtin_bit_cast(float, (unsigned)tok[t * 8 + 3 * s + 2]) * (1.0f / (F8_WSCALE * F8_ACTSCALE));        tok[t * 8 + 6 + s] = row; } }
    }
}
__device__ __forceinline__ void add_moe_row(const Ctx& X, f32x4 (&x)[8], int r, int e) {
    const bf16* ys = (const bf16*)(X.ws + R_YS); const float* slab = (const float*)(X.ws + R_SLAB);
    const int S = (int)X.misc[33], nnorm = (int)X.misc[32], nt = (int)X.misc[16 + e], tb = (int)X.misc[24 + e], rt = (r >> 8) - tb;
    const v2u* y = (const v2u*)(ys + (size_t)r * D) + X.lane;
#pragma unroll
    for (int j = 0; j < 8; ++j) { const int Lw = 8 * tb + j * nt + rt;
        if (S > 1 && Lw >= nnorm) { const float* sp = slab + (size_t)((Lw - nnorm) * S) * 65536 + (size_t)(r & 255) * 256 + 4 * X.lane;
            for (int q = 0; q < S; ++q) x[j] += *(const f32x4*)(sp + (size_t)q * 65536); }
        else { const v2u a = y[64 * j]; x[j][0] += bf2f(a.x & 0xffffu); x[j][1] += bf2f(a.x >> 16); x[j][2] += bf2f(a.y & 0xffffu); x[j][3] += bf2f(a.y >> 16); } }
}
__device__ __forceinline__ void final_phase(const Ctx& X) {
    moe_tables(X);
    const float* xres = (const float*)(X.ws + WS_XRES); const int* tok = (const int*)(X.ctl + CW_TOK); const float* gf = X.in(I_NORM_FINAL);
    f32x4 g[8];
#pragma unroll
    for (int j = 0; j < 8; ++j) g[j] = *((const f32x4*)gf + X.lane + 64 * j);
    for (int t = X.bid * 8 + X.wave; t < L; t += X.G * 8) {
        const int e0 = tok[t * 8 + 0], e1 = tok[t * 8 + 3], r0 = tok[t * 8 + 6], r1 = tok[t * 8 + 7];
        const f32x4* xr = (const f32x4*)(xres + (size_t)t * D) + X.lane; f32x4 v[8];
#pragma unroll
        for (int j = 0; j < 8; ++j) v[j] = xr[64 * j];
        add_moe_row(X, v, r0, e0); add_moe_row(X, v, r1, e1);
        float s = 0.f;
#pragma unroll
        for (int j = 0; j < 8; ++j) s += (v[j][0] * v[j][0] + v[j][1] * v[j][1]) + (v[j][2] * v[j][2] + v[j][3] * v[j][3]);
        const float rs = __builtin_amdgcn_rsqf(wave_sum(s) * (1.0f / D) + RMS_EPS);
        f32x4* o = (f32x4*)(X.out + (size_t)t * D) + X.lane;
#pragma unroll
        for (int j = 0; j < 8; ++j) o[64 * j] = v[j] * rs * g[j];
    }
}
constexpr int N_PHASES = 22;
struct Args { const float* in[N_IN]; float* out; unsigned char* ws; int ph_lo, ph_hi; };
static_assert(sizeof(Args) == (N_IN + 2) * 8 + 8, "Args has no padding");
__global__ void __launch_bounds__(512, 2) fwd_kernel(Args args) {
    extern __shared__ __attribute__((aligned(16))) unsigned char lds_raw[];
    Ctx X;
    X.out = args.out; X.ws = args.ws; X.ctl = (unsigned*)(args.ws + WS_CTL); X.lds = (LAS unsigned char*)lds_raw; X.misc = (volatile LAS unsigned*)(X.lds + LDS_MISC);
    X.tid = threadIdx.x; X.lane = X.tid & 63; X.wave = __builtin_amdgcn_readfirstlane(X.tid >> 6); X.G = gridDim.x; X.bid = blockIdx.x;
    if (X.tid < 64) X.misc[X.tid] = 0u;
    if (X.tid == 0) {
#pragma unroll
        for (int i = 0; i < N_IN; ++i) { const unsigned long long v = (unsigned long long)args.in[i]; X.misc[64 + 2 * i] = (unsigned)v; X.misc[65 + 2 * i] = (unsigned)(v >> 32); } }
    __syncthreads();
    const int lo = args.ph_lo, hi = args.ph_hi;
    XcdBarrier bar; bar.bar = X.ctl + CW_BAR; bar.x = 0; bar.st = nullptr;
    if (hi - lo > 1) bar = xcd_barrier_post(X.ctl + CW_BAR, X.misc + 8);
#ifndef EN_MASK
#define EN_MASK 0xFFFF
#endif
#define EN(b) (((EN_MASK) >> (b)) & 1)
#define IN(k) (lo <= (k) && (k) < hi)
#ifndef DUP_MASK
#define DUP_MASK 0
#endif
#define DUPX(b) (1 + (((DUP_MASK) >> (b)) & 1))
#define REP(b) for (int rep_ = 0; rep_ < 1 + (((DUP_MASK) >> (b)) & 1); ++rep_)
#define SEAM(k) do { if (IN(k) && IN((k) + 1)) xcd_barrier(bar); } while (0)
#define PHX(Y) Ctx Y = X; { int t_ = threadIdx.x; asm volatile("" : "+v"(t_)); Y.tid = t_; Y.lane = t_ & 63; }
    unsigned char* ws = X.ws; u64* sumsq = (u64*)(X.ctl + CW_SUMSQ);
    LAS unsigned char* lds = X.lds;

    if (EN(0) && IN(0)) { PHX(Y) p0_misc<0>(Y); __syncthreads(); }
    SEAM(0);
    if (EN(1) && IN(1)) {
#pragma unroll 1
        for (int lf = 0; lf < 2; ++lf) { SchedGrid S{X.G, X.bid, 16, 32, (const char*)(ws + WS_W4T + (size_t)lf * 4096 * 256 * 2), (const char*)(ws + WS_H3B + (size_t)lf * L * 256 * 2), (size_t)256 * 256 * 2};
          EpiBf16Plain E{(bf16*)(ws + (lf ? R_K4T1 : R_K4T)), L}; int kf = 256; asm volatile("" : "+s"(kf));
          pg8::gemm_phase(lds, kf, S, E); __syncthreads(); }
        { PHX(Y) p0_misc<1>(Y); __syncthreads(); }
        { PHX(Y) p0_weights(Y, 0, IT_WIN / 2); __syncthreads(); }
    }
    if (IN(1)) xcd_barrier(bar);
    if (EN(1) && IN(1)) {
        const bool cfirst = ((X.bid >> 3) & 1) != 0;
        if (!cfirst) { PHX(Y) p0_weights(Y, IT_WIN / 2, IT_TOTAL); __syncthreads(); }
        { PHX(Y) fft_tables((LAS cpxv*)Y.lds, Y.tid, (const cpxv*)(ws + WS_TW)); }
        { PHX(Y) for (int it = X.bid; it < 2048; it += X.G) spectra_task(Y, it >> 10, (it >> 9) & 1, it & 511, (const bf16*)(ws + ((it >> 10) ? R_K4T1 : R_K4T))); }
        __syncthreads();
        { PHX(Y) lr_phase(Y, 0, sumsq); }
        { SchedWin S{X.G, X.bid, (const char*)(ws + WS_W + W_HY), (const char*)(ws + WS_W + W_REST), (const char*)(ws + WS_XB)};
          EpiWin E{(bf16*)(ws + R_UT), (bf16*)(ws + R_QKVR), (bf16*)(ws + R_SG), sumsq}; pg8::gemm_phase(lds, D, S, E); }
        __syncthreads();
        if (cfirst) { PHX(Y) p0_weights(Y, IT_WIN / 2, IT_TOTAL); __syncthreads(); }
    }
    SEAM(1);
#pragma unroll 1
    for (int l = 0; l < 2; ++l) {
        const int P = 1 + 9 * l;
        const size_t WL = WS_W + (size_t)l * W_LAYER;
        const u64* ss_mix = sumsq + (l == 0 ? 0 : 2 * L); u64* ss_ffn = sumsq + (l == 0 ? L : 3 * L);
        if (EN(2) && IN(P + 1) && l == 1) {
            { PHX(Y) lr_phase(Y, l, ss_mix); }
            REP(4) { SchedWin S{X.G, X.bid, (const char*)(ws + WL + W_HY), (const char*)(ws + WL + W_REST), (const char*)(ws + WS_XB)};
              EpiWin E{(bf16*)(ws + R_UT), (bf16*)(ws + R_QKVR), (bf16*)(ws + R_SG), ss_mix}; pg8::gemm_phase(lds, D, S, E); }
        }
        if (l == 1) SEAM(P + 1);
        if (EN(3) && IN(P + 2)) { PHX(Y) for (int it = X.bid; it < 512 * DUPX(7); it += X.G) gla_g1(Y, l, (it >> 7) & 3, it & 127); }
        SEAM(P + 2);
        if (EN(4) && IN(P + 3)) {
            { PHX(Y) fft_tables((LAS cpxv*)Y.lds, Y.tid, (const cpxv*)(ws + WS_TW)); }
            { PHX(Y) constexpr int NEL = 2 * NH * DV * DK / 2; BgScan bg; bg.init(Y, (X.bid * 512 + Y.tid) % NEL);
              for (int it = X.bid; it < 512 * DUPX(6); it += X.G) hyena_task(Y, l, it & 511, bg);
              bg.finish();
              gla_g2(Y, X.bid * 512 + Y.tid + X.G * 512); }
        }
        SEAM(P + 3);
        if (EN(5) && IN(P + 4)) { { PHX(Y) for (int it = X.bid; it < 512 * DUPX(9); it += X.G) gla_g3(Y, l, (it >> 7) & 3, it & 127); } REP(10) { PHX(Y) hy_transpose(Y); } }
        SEAM(P + 4);
        if (EN(6) && IN(P + 5)) REP(11) { SchedBranch S{X.G, X.bid, (const char*)(ws + R_HY), (const char*)(ws + R_GLA), (const char*)(ws + WL + W_A), (const char*)(ws + WL + W_B)};
            EpiBranch E{(const bf16*)(ws + R_SG), (bf16*)(ws + R_MIXED)}; pg8::gemm_phase(lds, 1024, S, E); }
        SEAM(P + 5);
        if (EN(7) && IN(P + 6)) { SchedGrid S{X.G, X.bid, 32, 8, (const char*)(ws + R_MIXED), (const char*)(ws + WL + W_O), (size_t)256 * D * 2};
            if (l == 0) { EpiResid<1> E{X.in(I_X), (float*)(ws + WS_XRES), (bf16*)(ws + WS_XB), ss_ffn}; pg8::gemm_phase(lds, D, S, E); }
            else { EpiResid<2> E{(const float*)(ws + WS_XRES), (float*)(ws + WS_XRES), nullptr, ss_ffn}; pg8::gemm_phase(lds, D, S, E); } }
        SEAM(P + 6);
        if (l == 0) {
            if (EN(8) && IN(8)) REP(12) { SchedGrid S{X.G, X.bid, 32, 44, (const char*)(ws + WS_XB), (const char*)(ws + WS_WFF + W_GU), (size_t)256 * D};
                EpiSwiglu E{(bf16*)(ws + R_ACT), ss_ffn, nullptr, 1.0f / (F8_WSCALE * F8_ASCALE)}; pg8::gemm_phase<EpiSwiglu, SchedGrid, true>(lds, D / 2, S, E); }
            SEAM(8);
            if (EN(9) && IN(9)) { SchedGrid S{X.G, X.bid, 32, 8, (const char*)(ws + R_ACT), (const char*)(ws + WS_WFF + W_DT), (size_t)256 * FF * 2};
                EpiResid<0> E{(const float*)(ws + WS_XRES), (float*)(ws + WS_XRES), (bf16*)(ws + WS_XB), sumsq + 2 * L}; pg8::gemm_phase(lds, FF, S, E); }
            SEAM(9);
        }
    }
    if (EN(10) && IN(17)) { PHX(Y) router_phase(Y, sumsq + 3 * L); }
    SEAM(17);
    if (EN(11) && IN(18)) { PHX(Y) gather_phase(Y, sumsq + 3 * L); }
    SEAM(18);
    if (EN(12) && IN(19)) REP(13) { moe_tables(X);
        const int vcu = (X.G % 8 == 0) ? (X.bid % 8) * (X.G / 8) + X.bid / 8 : X.bid;
        SchedMoe S{X.G, vcu, 44, 1 << 30, (const char*)(ws + R_XG), (const char*)(ws + WS_WFF + W_FFN + W_GU), (size_t)256 * D, W_FFN, X.misc};
        EpiSwigluT<true> E{(bf16*)(ws + R_ACTG), nullptr, (const float*)(ws + WS_ROWSCALE), 1.0f}; pg8::gemm_phase<EpiSwigluT<true>, SchedMoe, true>(lds, D / 2, S, E); }
    SEAM(19);
    if (EN(13) && IN(20)) REP(15) { moe_tables(X);
        const int vcu = (X.G % 8 == 0) ? (X.bid % 8) * (X.G / 8) + X.bid / 8 : X.bid;
        { SchedMoe S{X.G, vcu, 8, (int)X.misc[32], (const char*)(ws + R_ACTG), (const char*)(ws + WS_WFF + W_FFN + W_DT), (size_t)256 * FF, W_FFN, X.misc};
          EpiMoeDown E{(bf16*)(ws + R_YS), (const float*)(ws + WS_ROWGATE)}; pg8::gemm_phase<EpiMoeDown, SchedMoe, true>(lds, FF / 2, S, E); }
        const int Ssp = (int)X.misc[33];
        if (Ssp > 1) { SchedMoeSplit S{X.bid, (const char*)(ws + R_ACTG), (const char*)(ws + WS_WFF + W_FFN + W_DT), (size_t)256 * FF, W_FFN, X.misc};
          EpiMoeDownSplit E{(float*)(ws + R_SLAB), (const float*)(ws + WS_ROWGATE)}; pg8::gemm_phase<EpiMoeDownSplit, SchedMoeSplit, true>(lds, FF / 2, S, E, moe_split_tiles(Ssp, X.bid % Ssp)); } }
    SEAM(20);
    if (EN(14) && IN(21)) REP(14) { PHX(Y) final_phase(Y); }
#undef IN
#undef SEAM
}

extern "C" void kernel_launch(void* const* d_in, const int* in_sizes, int n_in, void* d_out, int out_size, void* d_ws, size_t ws_size, hipStream_t stream) {
    static int grid = 0;
    if (grid == 0) {
        if (n_in != N_IN || out_size != L * D || ws_size < WS_END) { fprintf(stderr, "kernel_launch: unexpected shapes (n_in %d, out %d, ws %zu < %zu)\n", n_in, out_size, ws_size, (size_t)WS_END); grid = -1; return; }
        int dev = 0, cus = 0, per_cu = 0;
        if (hipGetDevice(&dev) != hipSuccess || hipDeviceGetAttribute(&cus, hipDeviceAttributeMultiprocessorCount, dev) != hipSuccess) { grid = -1; return; }
        if (hipFuncSetAttribute((const void*)fwd_kernel, hipFuncAttributeMaxDynamicSharedMemorySize, LDS_BYTES) != hipSuccess) { fprintf(stderr, "kernel_launch: hipFuncSetAttribute failed\n"); grid = -1; return; }
        if (hipOccupancyMaxActiveBlocksPerMultiprocessor(&per_cu, (const void*)fwd_kernel, 512, LDS_BYTES) != hipSuccess || per_cu < 1) { fprintf(stderr, "kernel_launch: occupancy query says %d\n", per_cu); }
        (void)hipGetLastError();
        grid = cus;
    }
    if (grid < 0) return;
    if (hipMemsetAsync((char*)d_ws + WS_CTL, 0, CTL_ZERO_BYTES, stream) != hipSuccess) return;
    Args a{};
    for (int i = 0; i < N_IN; ++i) a.in[i] = (const float*)d_in[i];
    a.out = (float*)d_out; a.ws = (unsigned char*)d_ws;
#if MK_ONE_LAUNCH
    a.ph_lo = 0; a.ph_hi = N_PHASES;
    hipLaunchKernelGGL(fwd_kernel, dim3(grid), dim3(512), LDS_BYTES, stream, a);
#else
    for (int p = 0; p < N_PHASES; ++p) { a.ph_lo = p; a.ph_hi = p + 1; hipLaunchKernelGGL(fwd_kernel, dim3(grid), dim3(512), LDS_BYTES, stream, a); }
#endif
}
```
